# Optimizing an MI355X kernel written in HIP

```python
import jax, jax.numpy as jnp
from jax import lax
import numpy as np

D_MODEL = 1024
BATCH = 4
SEQ = 4096
DEPTH = 1
DEC_BATCH = 8
DEC_SEQ = 8192
PAST_LEN = 128

GRID_W = 64
D_FOURIER = D_MODEL // 2
N_FGROUPS = 4
FG_DIM = D_FOURIER // N_FGROUPS
D_NA = D_MODEL - D_FOURIER
N_HEADS = 8
HEAD_DIM = D_NA // N_HEADS
MAX_WIN_ROWS = 8
WIN_COLS = 16
RPB_ROWS = 2 * MAX_WIN_ROWS - 1
RPB_COLS = 2 * WIN_COLS - 1
D_IN = D_FOURIER + 3 * D_NA
D_FF = -(-8 * D_MODEL // (3 * 256)) * 256
N_MOD = 6
EPS = 1e-6

kernel_name = "hymba_fnet_natten_encoder"


def rmsnorm(x, g):
    xf = x.astype(jnp.float32)
    y = xf * lax.rsqrt(jnp.mean(xf * xf, axis=-1, keepdims=True) + EPS)
    return (y * g.astype(jnp.float32)).astype(x.dtype)


def fourier_mix(u, w_fmix):
    b, t, _ = u.shape
    ug = u.reshape(b, t, N_FGROUPS, FG_DIM).astype(jnp.float32)
    f = jnp.fft.fft2(ug, axes=(1, 3), norm="ortho").real.astype(u.dtype)
    out = jnp.einsum('btgc,gcd->btgd', f, w_fmix)
    return out.reshape(b, t, D_FOURIER)


def neighbourhood_attention(q, k, v, rpb):
    b, t, h, dh = q.shape
    rows = t // GRID_W
    kh = min(MAX_WIN_ROWS, rows)
    q5 = q.reshape(b, rows, GRID_W, h, dh)
    k5 = k.reshape(b, rows, GRID_W, h, dh)
    v5 = v.reshape(b, rows, GRID_W, h, dh)
    cols = np.arange(GRID_W)
    col_start = np.clip(cols - WIN_COLS // 2, 0, GRID_W - WIN_COLS)
    col_idx = col_start[:, None] + np.arange(WIN_COLS)[None, :]
    dc = col_idx - cols[:, None] + (WIN_COLS - 1)
    scale = HEAD_DIM ** -0.5

    def row_step(args):
        qi, i = args
        rs = jnp.clip(i - kh // 2, 0, rows - kh)
        kwin = lax.dynamic_slice_in_dim(k5, rs, kh, axis=1)
        vwin = lax.dynamic_slice_in_dim(v5, rs, kh, axis=1)
        kc = kwin[:, :, col_idx]
        vc = vwin[:, :, col_idx]
        dr = rs + jnp.arange(kh) - i + (MAX_WIN_ROWS - 1)
        bias = rpb[:, dr[None, :, None], dc[:, None, :]]
        bias = jnp.transpose(bias, (1, 0, 2, 3)).astype(jnp.float32)
        s = jnp.einsum('bqhd,brqkhd->bqhrk', qi, kc,
                       preferred_element_type=jnp.float32) * scale + bias[None]
        p = jax.nn.softmax(s.reshape(b, GRID_W, h, kh * WIN_COLS), axis=-1)
        p = p.reshape(b, GRID_W, h, kh, WIN_COLS).astype(v.dtype)
        return jnp.einsum('bqhrk,brqkhd->bqhd', p, vc)

    out = lax.map(row_step, (jnp.transpose(q5, (1, 0, 2, 3, 4)), jnp.arange(rows)))
    return jnp.transpose(out, (1, 0, 2, 3, 4)).reshape(b, t, h * dh)


def encoder_layer(x, c, w_ada, b_ada, g_attn, w_in, g_q, g_k, w_fmix, rpb,
                  g_fout, g_aout, w_o, g_ffn, w_gate, w_up, w_down):
    b, t, _ = x.shape
    mod = (jax.nn.silu(c) @ w_ada + b_ada)[:, None, :]
    shift1, scale1, gate1, shift2, scale2, gate2 = jnp.split(mod, N_MOD, axis=-1)

    h = rmsnorm(x, g_attn) * (1 + scale1) + shift1
    z = h @ w_in
    u, q, k, v = jnp.split(z, [D_FOURIER, D_FOURIER + D_NA, D_FOURIER + 2 * D_NA], axis=-1)
    q = rmsnorm(q.reshape(b, t, N_HEADS, HEAD_DIM), g_q)
    k = rmsnorm(k.reshape(b, t, N_HEADS, HEAD_DIM), g_k)
    v = v.reshape(b, t, N_HEADS, HEAD_DIM)
    f_out = fourier_mix(u, w_fmix)
    a_out = neighbourhood_attention(q, k, v, rpb)
    mix = jnp.concatenate([rmsnorm(f_out, g_fout), rmsnorm(a_out, g_aout)], axis=-1) @ w_o
    x = x + gate1 * mix

    h2 = rmsnorm(x, g_ffn) * (1 + scale2) + shift2
    ff = (jax.nn.silu(h2 @ w_gate) * (h2 @ w_up)) @ w_down
    return x + gate2 * ff


def setup_inputs(seed: int = 0) -> dict:
    key = jax.random.key(seed)
    ks = jax.random.split(key, 20)
    f32 = jnp.float32
    nrm = lambda k, shape, s: jax.random.normal(k, shape, f32) * s
    gain = lambda k, shape: 1.0 + 0.01 * jax.random.normal(k, shape, f32)
    L = DEPTH
    return {
        "x_prompt": nrm(ks[0], (BATCH, SEQ, D_MODEL), 1.0),
        "x_sample": nrm(ks[1], (DEC_BATCH, DEC_SEQ, D_MODEL), 1.0),
        "c_prompt": nrm(ks[2], (BATCH, D_MODEL), 1.0),
        "c_sample": nrm(ks[3], (DEC_BATCH, D_MODEL), 1.0),
        "w_ada": nrm(ks[4], (L, D_MODEL, N_MOD * D_MODEL), D_MODEL ** -0.5),
        "b_ada": nrm(ks[5], (L, N_MOD * D_MODEL), 0.01),
        "g_attn": gain(ks[6], (L, D_MODEL)),
        "w_in": nrm(ks[7], (L, D_MODEL, D_IN), D_MODEL ** -0.5),
        "g_q": gain(ks[8], (L, HEAD_DIM)),
        "g_k": gain(ks[9], (L, HEAD_DIM)),
        "w_fmix": nrm(ks[10], (L, N_FGROUPS, FG_DIM, FG_DIM), FG_DIM ** -0.5),
        "rpb": nrm(ks[11], (L, N_HEADS, RPB_ROWS, RPB_COLS), 0.02),
        "g_fout": gain(ks[12], (L, D_FOURIER)),
        "g_aout": gain(ks[13], (L, D_NA)),
        "w_o": nrm(ks[14], (L, D_MODEL, D_MODEL), D_MODEL ** -0.5),
        "g_ffn": gain(ks[15], (L, D_MODEL)),
        "w_gate": nrm(ks[16], (L, D_MODEL, D_FF), D_MODEL ** -0.5),
        "w_up": nrm(ks[17], (L, D_MODEL, D_FF), D_MODEL ** -0.5),
        "w_down": nrm(ks[18], (L, D_FF, D_MODEL), D_FF ** -0.5),
    }


def reference(x_prompt, x_sample, c_prompt, c_sample, w_ada, b_ada, g_attn, w_in, g_q, g_k,
              w_fmix, rpb, g_fout, g_aout, w_o, g_ffn, w_gate, w_up, w_down):
    def trunk(x, c):
        for l in range(DEPTH):
            x = encoder_layer(x, c, w_ada[l], b_ada[l], g_attn[l], w_in[l], g_q[l], g_k[l],
                              w_fmix[l], rpb[l], g_fout[l], g_aout[l], w_o[l], g_ffn[l],
                              w_gate[l], w_up[l], w_down[l])
        return x

    y_prompt = trunk(x_prompt, c_prompt)
    y_sample = trunk(x_sample, c_sample)
    return (y_prompt, y_sample)
```

```cpp
#include <hip/hip_runtime.h>
#include <hip/hip_cooperative_groups.h>
#include <cstdio>
#include <cstdint>
namespace cg = cooperative_groups;

namespace pg8 {
#define PG8_LAS __attribute__((address_space(3)))
typedef unsigned short bf16_t;
typedef short bf16x8 __attribute__((ext_vector_type(8)));
typedef float f32x4 __attribute__((ext_vector_type(4)));
typedef unsigned u32x4 __attribute__((ext_vector_type(4)));
constexpr int BM = 256, BK = 64, HALF = 128, HTB = HALF * BK * 2  , STAGE_BYTES = 8 * HTB, NXCD = 8, WGM = 4;

__host__ __device__ __forceinline__ int lds_byte(int r, int c) { const int st = (r >> 4) * 2 + (c >> 5), rr = r & 15, cc = c & 31, ob = rr * 64 + cc * 2; return st * 1024 + (ob ^ (((ob >> 9) & 1) << 5)); }
__host__ __device__ __forceinline__ void stage_rc(int b, int& R, int& C) { const int st = b / 1024, sb = b % 1024, swz = sb ^ (((sb >> 9) & 1) << 5); R = (st >> 1) * 16 + swz / 64; C = (st & 1) * 32 + (swz % 64) / 2; }
__host__ __device__ __forceinline__ int perm32(int rho) { const int n = rho >> 4, i = rho & 15; return 8 * (i >> 2) + 4 * n + (i & 3); }

struct Unit { int pm, pn; };
struct Gemm { const bf16_t* A; const bf16_t* Bt; int M, N, K; };

struct StaticOrder {
    static constexpr bool CUSTOMB = false;
    int nM, nN, nwg, G, c;
    __host__ __device__ void init(int M, int N, int G_, int c_) { nM = M / BM; nN = N / BM; nwg = nM * nN; G = G_; c = c_; }
    __host__ __device__ bool next(int i, Unit& u) const {
        const long L = (long)i * G + c; if (L >= nwg) return false;
        int wgid = (int)L; { const int q = nwg / NXCD, r = nwg % NXCD, xcd = wgid % NXCD, off = wgid / NXCD; wgid = (xcd < r ? xcd * (q + 1) : r * (q + 1) + (xcd - r) * q) + off; }
        const int nig = WGM * nN, gid = wgid / nig, fm = gid * WGM, gsz = (nM - fm) < WGM ? (nM - fm) : WGM;
        u.pm = fm + ((wgid % nig) % gsz); u.pn = (wgid % nig) / gsz; return true;
    }
    __device__ __forceinline__ void a_ready(const Unit&) const {}
    __device__ __forceinline__ void done(const Unit&) const {}
};

__device__ __forceinline__ unsigned cvt_pk_bf16(float lo, float hi) { unsigned r; asm volatile("v_cvt_pk_bf16_f32 %0, %1, %2" : "=v"(r) : "v"(lo), "v"(hi)); return r; }
template <class Epi, class Sched, bool ALIGN_EPI = false, bool SP2 = false>
__device__ __forceinline__ void gemm_phase(PG8_LAS unsigned char* lds, const Gemm g, const Sched& S, const Epi& E) {
    const int tid = threadIdx.x, wid = __builtin_amdgcn_readfirstlane(tid >> 6), lane = tid & 63, wr = wid >> 2, wc = wid & 3, fr = lane & 15, fq = lane >> 4;
    const int K = g.K, nt = K / BK;
    unsigned voffA[2], voffB[2];
#pragma unroll
    for (int i = 0; i < 2; ++i) { int R, C; stage_rc(tid * 16 + i * 8192, R, C); const int Rb = Epi::PERM ? ((R & ~31) + perm32(R & 31)) : R;
        voffA[i] = (unsigned)(R * K + C) * 2u; if constexpr (Sched::CUSTOMB) voffB[i] = S.b_voff(Rb, C, K); else voffB[i] = (unsigned)(Rb * K + C) * 2u; }
    const size_t kstep = (size_t)(BK * 2);
    const size_t hstep = (size_t)HALF * K * 2;
    const size_t tstep = 2 * hstep;
    size_t hstepB = hstep; if constexpr (Sched::CUSTOMB) hstepB = S.b_hstep(K);
    const unsigned ldsw = (unsigned)wid * 1024u;
    const int aoff = lds_byte(wr * 64 + fr, fq * 8), boff = lds_byte(wc * 32 + fr, fq * 8);
#define PG8_SA(b, h) (((b) * 2 + (h)) * HTB)
#define PG8_SB(b, h) ((4 + (b) * 2 + (h)) * HTB)
#define PG8_STAGE(bufoff, gbase, voff) do { _Pragma("unroll") for (int _i = 0; _i < 2; ++_i) \
        __builtin_amdgcn_global_load_lds((const unsigned*)((const char*)(gbase) + (voff)[_i]), (PG8_LAS unsigned*)(lds + (bufoff) + ldsw + _i * 8192), 16, 0, 0); } while (0)
#define PG8_LDA(dst, b, h) do { _Pragma("unroll") for (int m = 0; m < 4; ++m) _Pragma("unroll") for (int k = 0; k < 2; ++k) dst[m][k] = *(const PG8_LAS bf16x8*)(lds + PG8_SA(b, h) + aoff + m * 2048 + k * 1024); } while (0)
#define PG8_LDB(dst, b, h) do { _Pragma("unroll") for (int n = 0; n < 2; ++n) _Pragma("unroll") for (int k = 0; k < 2; ++k) dst[n][k] = *(const PG8_LAS bf16x8*)(lds + PG8_SB(b, h) + boff + n * 2048 + k * 1024); } while (0)
#define PG8_MMA(ai, bj, At, Bt) do { __builtin_amdgcn_s_setprio(1); _Pragma("unroll") for (int m = 0; m < 4; ++m) _Pragma("unroll") for (int n = 0; n < 2; ++n) _Pragma("unroll") for (int k = 0; k < 2; ++k) \
        acc[ai][bj][m][n] = __builtin_amdgcn_mfma_f32_16x16x32_bf16(Bt[n][k], At[m][k], acc[ai][bj][m][n], 0, 0, 0); __builtin_amdgcn_s_setprio(0); } while (0)
#define PG8_WAIT_V(n) asm volatile("s_waitcnt vmcnt(" #n ")" ::: "memory")
#define PG8_WAIT_L(n) asm volatile("s_waitcnt lgkmcnt(" #n ")" ::: "memory")
#define PG8_BAR __builtin_amdgcn_s_barrier()
#define PG8_SCHED __builtin_amdgcn_sched_barrier(0)
    Unit cur, nxt; int ui = 0;
    if (!S.next(0, cur)) return;
    f32x4 acc[2][2][4][2];
#pragma unroll
    for (int a = 0; a < 2; ++a)
#pragma unroll
        for (int b = 0; b < 2; ++b)
#pragma unroll
            for (int m = 0; m < 4; ++m)
#pragma unroll
                for (int n = 0; n < 2; ++n) acc[a][b][m][n] = (f32x4){0.f, 0.f, 0.f, 0.f};
    bf16x8 At[4][2], B0[2][2], B1[2][2];
    const char* cA = (const char*)g.A + (size_t)cur.pm * tstep; const char* cB; if constexpr (Sched::CUSTOMB) cB = (const char*)g.Bt + S.b_off(cur.pn, K); else cB = (const char*)g.Bt + (size_t)cur.pn * tstep;
    S.a_ready(cur);
    if constexpr (SP2) {
        PG8_STAGE(PG8_SB(0, 0), cB, voffB); PG8_STAGE(PG8_SB(0, 1), cB + hstepB, voffB); PG8_STAGE(PG8_SA(0, 0), cA, voffA); PG8_STAGE(PG8_SA(0, 1), cA + hstep, voffA);
        if (wr == 1) PG8_BAR;
        PG8_WAIT_V(2); PG8_BAR;
        PG8_STAGE(PG8_SB(1, 0), cB + kstep, voffB); PG8_STAGE(PG8_SA(1, 0), cA + kstep, voffA); PG8_STAGE(PG8_SB(1, 1), cB + hstepB + kstep, voffB);
        PG8_WAIT_V(6); PG8_BAR;
    } else {
        PG8_STAGE(PG8_SB(0, 0), cB, voffB); PG8_STAGE(PG8_SA(0, 0), cA, voffA); PG8_STAGE(PG8_SB(0, 1), cB + hstepB, voffB); PG8_STAGE(PG8_SA(0, 1), cA + hstep, voffA);
        if (wr == 1) PG8_BAR;
        PG8_WAIT_V(4); PG8_BAR;
        PG8_STAGE(PG8_SB(1, 0), cB + kstep, voffB); PG8_STAGE(PG8_SA(1, 0), cA + kstep, voffA); PG8_STAGE(PG8_SB(1, 1), cB + hstepB + kstep, voffB);
        PG8_WAIT_V(6); PG8_BAR;
    }
    for (;;) {
        const bool has_next = S.next(ui + 1, nxt);
        const char* nA = has_next ? (const char*)g.A + (size_t)nxt.pm * tstep : cA; const char* nB; if constexpr (Sched::CUSTOMB) nB = has_next ? (const char*)g.Bt + S.b_off(nxt.pn, K) : cB; else nB = has_next ? (const char*)g.Bt + (size_t)nxt.pn * tstep : cB;
        for (int seg = 0; seg < (Epi::MIDK ? 2 : 1); ++seg) {
        int t_lo = 0, t_hi = nt;
        if constexpr (Epi::MIDK) { if (seg == 0) t_hi = Epi::MIDT; else { t_lo = Epi::MIDT; E.mid(acc, ui, wr, wc, fr, fq); } }
        for (int t = t_lo; t < t_hi; t += 2) {
            const bool last = (t == nt - 2);
            const char* a1 = cA + (size_t)(t + 1) * kstep;
            const char* a2 = last ? nA : cA + (size_t)(t + 2) * kstep; const char* b2 = last ? nB : cB + (size_t)(t + 2) * kstep;
            const char* a3 = a2 + kstep; const char* b3 = b2 + kstep;
            if (last && has_next) S.a_ready(nxt);
            if constexpr (SP2) {
            PG8_LDB(B0, 0, 0); PG8_LDB(B1, 0, 1); PG8_SCHED; PG8_LDA(At, 0, 0); PG8_STAGE(PG8_SA(1, 1), a1 + hstep, voffA);
            PG8_WAIT_V(8); PG8_WAIT_L(0); PG8_BAR; PG8_MMA(0, 0, At, B0); PG8_MMA(0, 1, At, B1); PG8_BAR; PG8_SCHED;
            PG8_LDA(At, 0, 1); PG8_STAGE(PG8_SB(0, 0), b2, voffB); PG8_STAGE(PG8_SB(0, 1), b2 + hstepB, voffB); PG8_STAGE(PG8_SA(0, 0), a2, voffA);
            PG8_WAIT_V(8); PG8_WAIT_L(0); PG8_BAR; PG8_MMA(1, 0, At, B0); PG8_MMA(1, 1, At, B1); PG8_BAR; PG8_SCHED;
            PG8_LDB(B0, 1, 0); PG8_LDB(B1, 1, 1); PG8_SCHED; PG8_LDA(At, 1, 0); PG8_STAGE(PG8_SA(0, 1), a2 + hstep, voffA);
            PG8_WAIT_V(8); PG8_WAIT_L(0); PG8_BAR; PG8_MMA(0, 0, At, B0); PG8_MMA(0, 1, At, B1); PG8_BAR; PG8_SCHED;
            PG8_LDA(At, 1, 1); PG8_STAGE(PG8_SB(1, 0), b3, voffB); PG8_STAGE(PG8_SB(1, 1), b3 + hstepB, voffB); PG8_STAGE(PG8_SA(1, 0), a3, voffA);
            PG8_WAIT_V(8); PG8_WAIT_L(0); PG8_BAR; PG8_MMA(1, 0, At, B0); PG8_MMA(1, 1, At, B1); PG8_BAR; PG8_SCHED;
            } else {
            PG8_LDB(B0, 0, 0); PG8_SCHED; PG8_LDA(At, 0, 0); PG8_STAGE(PG8_SA(1, 1), a1 + hstep, voffA);
            PG8_WAIT_L(8); PG8_BAR; PG8_WAIT_L(0); PG8_MMA(0, 0, At, B0); PG8_BAR; PG8_SCHED;
            PG8_LDB(B1, 0, 1); PG8_STAGE(PG8_SB(0, 0), b2, voffB);
            PG8_BAR; PG8_WAIT_L(0); PG8_MMA(0, 1, At, B1); PG8_BAR;
            PG8_LDA(At, 0, 1); PG8_STAGE(PG8_SA(0, 0), a2, voffA);
            PG8_BAR; PG8_WAIT_L(0); PG8_MMA(1, 0, At, B0); PG8_BAR; PG8_SCHED;
            PG8_STAGE(PG8_SB(0, 1), b2 + hstepB, voffB);
            PG8_WAIT_V(6); PG8_BAR; PG8_MMA(1, 1, At, B1); PG8_BAR;
            PG8_LDB(B0, 1, 0); PG8_SCHED; PG8_LDA(At, 1, 0); PG8_STAGE(PG8_SA(0, 1), a2 + hstep, voffA);
            PG8_WAIT_L(8); PG8_BAR; PG8_WAIT_L(0); PG8_MMA(0, 0, At, B0); PG8_BAR; PG8_SCHED;
            PG8_LDB(B1, 1, 1); PG8_STAGE(PG8_SB(1, 0), b3, voffB);
            PG8_BAR; PG8_WAIT_L(0); PG8_MMA(0, 1, At, B1); PG8_BAR;
            PG8_LDA(At, 1, 1); PG8_STAGE(PG8_SA(1, 0), a3, voffA);
            PG8_BAR; PG8_WAIT_L(0); PG8_MMA(1, 0, At, B0); PG8_BAR; PG8_SCHED;
            PG8_STAGE(PG8_SB(1, 1), b3 + hstepB, voffB);
            PG8_WAIT_V(6); PG8_BAR; PG8_MMA(1, 1, At, B1); PG8_BAR;
            }
        }
        }
        if constexpr (ALIGN_EPI) { if (wr == 0) PG8_BAR; }
        if constexpr (!Epi::AFTER_DRAIN) { if constexpr (Epi::MIDK) E.fin(acc, cur, ui, wr, wc, fr, fq); else E(acc, cur, wr, wc, fr, fq); S.done(cur); }
        if (!has_next) break;
#pragma unroll
        for (int a = 0; a < 2; ++a)
#pragma unroll
            for (int b = 0; b < 2; ++b)
#pragma unroll
                for (int m = 0; m < 4; ++m)
#pragma unroll
                    for (int n = 0; n < 2; ++n) acc[a][b][m][n] = (f32x4){0.f, 0.f, 0.f, 0.f};
        cur = nxt; cA = nA; cB = nB; ++ui;
        if constexpr (ALIGN_EPI) { if (wr == 1) PG8_BAR; }
    }
    PG8_WAIT_V(0);
    if constexpr (!ALIGN_EPI) { if (wr == 0) PG8_BAR; }
    PG8_BAR;
    if constexpr (Epi::AFTER_DRAIN) { E.fused(acc, cur, wr, wc, fr, fq, lds, wid, lane); S.done(cur); }
#undef PG8_SA
#undef PG8_SB
#undef PG8_STAGE
#undef PG8_LDA
#undef PG8_LDB
#undef PG8_MMA
#undef PG8_WAIT_V
#undef PG8_WAIT_L
#undef PG8_BAR
#undef PG8_SCHED
}
}

#define GAS __attribute__((address_space(1)))
#define LAS __attribute__((address_space(3)))
typedef unsigned short bf16;
typedef unsigned v4u __attribute__((ext_vector_type(4)));
typedef unsigned v2u __attribute__((ext_vector_type(2)));
typedef float f32x4 __attribute__((ext_vector_type(4)));
typedef short bf16x8 __attribute__((ext_vector_type(8)));
using pg8::Unit;
using pg8::cvt_pk_bf16;

constexpr int D = 1024, TP = 4096, TS = 8192, NTOK_P = 4 * TP, NTOK_S = 8 * TS, NTOK = NTOK_P + NTOK_S;
constexpr int DFF = 2816, NMOD = 6144;
constexpr float EPS = 1e-6f;
constexpr size_t MiB = 1u << 20;
constexpr size_t WS_SSQ = 0;
constexpr size_t WS_SSQA = 320 * 1024;
constexpr size_t WS_SSQF = 640 * 1024;
constexpr size_t WS_BAR = 960 * 1024;
constexpr size_t WS_MOD = 1 * MiB;
constexpr size_t WS_CS = 1 * MiB + 512 * 1024;
constexpr size_t WS_ECH = 2 * MiB;
constexpr size_t WS_DAS = 2 * MiB + 256 * 1024;
constexpr size_t WS_DAP = 2 * MiB + 512 * 1024;
constexpr size_t WS_WQK = 4 * MiB;
constexpr size_t WS_WUV = 6 * MiB;
constexpr size_t WS_WO = 10 * MiB;
constexpr size_t WS_WGU = 12 * MiB;
constexpr size_t WS_WD = 24 * MiB;
constexpr size_t WS_H = 32 * MiB;
constexpr size_t WS_Q = 192 * MiB;
constexpr size_t WS_K = 272 * MiB;
constexpr size_t WS_VTP = 352 * MiB;
constexpr size_t WS_VTS = 368 * MiB;
constexpr size_t WS_UTP = 432 * MiB;
constexpr size_t WS_UTS = 464 * MiB;
constexpr size_t WS_YP = 592 * MiB;
constexpr size_t WS_YS = 624 * MiB;
constexpr size_t WS_HID = 192 * MiB;
constexpr size_t WS_DBS = 752 * MiB;
constexpr size_t WS_DBP = 760 * MiB;
constexpr size_t WS_XB = 640 * MiB;
constexpr size_t WS_CAT = 832 * MiB;
constexpr size_t WS_END = 992 * MiB;
constexpr int LDS_BYTES = 147456;
#ifndef AT_SPLIT
#define AT_SPLIT 3
#endif

struct Args {
    const float *xp, *xs, *cp, *cs, *w_ada, *b_ada, *g_attn, *w_in, *g_q, *g_k, *w_fmix, *rpb, *g_fout, *g_aout, *w_o, *g_ffn, *w_gate, *w_up, *w_down;
    float* out; unsigned char* ws; int ph_lo, ph_hi;
};

__device__ __forceinline__ float wave_sum(float v) {
#pragma unroll
    for (int o = 1; o < 64; o <<= 1) v += __shfl_xor(v, o);
    return v;
}
__device__ __forceinline__ int batch_of(int tok) { return tok < NTOK_P ? (tok >> 12) : 4 + ((tok - NTOK_P) >> 13); }
__device__ __forceinline__ float bf_lo(unsigned w) { return __uint_as_float(w << 16); }
__device__ __forceinline__ float bf_hi(unsigned w) { return __uint_as_float(w & 0xffff0000u); }

struct RowOrder {
    static constexpr bool CUSTOMB = false;
    int G, c, nN, pshift, pmask;
    __device__ bool next(int i, Unit& u) const { const long L = (long)i * G + c; if (L >= nN) return false; u.pm = ((int)L >> pshift) & pmask; u.pn = (int)L; return true; }
    __device__ __forceinline__ void a_ready(const Unit&) const {}
    __device__ __forceinline__ void done(const Unit&) const {}
};
template <int T1> struct UOrder {
    static constexpr bool CUSTOMB = true;
    int G, c, nN, tokbase;
    __device__ bool next(int i, Unit& u) const { const long L = (long)i * G + c; if (L >= 4L * nN) return false; u.pm = (int)(L & 3); u.pn = (int)(L >> 2); return true; }
    __device__ __forceinline__ void a_ready(const Unit&) const {}
    __device__ __forceinline__ void done(const Unit&) const {}
    __device__ __forceinline__ unsigned b_voff(int Rb, int C, int K) const { const int tokoff = (T1 == 128) ? Rb * 64 : ((Rb & 63) * 64 + (Rb >> 6)); return (unsigned)(tokoff * K + C) * 2u; }
    __device__ __forceinline__ size_t b_hstep(int K) const { return (size_t)((T1 == 128) ? 1 : 2) * K * 2; }
    __device__ __forceinline__ size_t b_off(int pn, int K) const {
        const int n0 = pn * 256; int tok;
        if (T1 == 128) tok = tokbase + (n0 >> 13) * 8192 + ((n0 & 8191) >> 7); else tok = tokbase + (n0 >> 12) * 4096 + ((n0 & 4095) >> 6);
        return (size_t)tok * K * 2;
    }
};

struct EpiQK {
    static constexpr bool MIDK = false; static constexpr bool PERM = true, AFTER_DRAIN = false;
    bf16* Q; bf16* K; const float* gq; const float* gk;
    __device__ __forceinline__ void operator()(const f32x4 (&acc)[2][2][4][2], const Unit& u, int wr, int wc, int fr, int fq) const {
        const bool isq = u.pn < 2; bf16* base = isq ? Q : K; const float* g = isq ? gq : gk; const float sc = isq ? 0.125f * 1.4426950408889634f : 1.0f;
        const int head = 4 * (u.pn & 1) + wc;
        f32x4 gv[2][2];
#pragma unroll
        for (int bj = 0; bj < 2; ++bj)
#pragma unroll
            for (int n = 0; n < 2; ++n) gv[bj][n] = *(const f32x4*)(g + 32 * bj + 8 * fq + 4 * n) * sc;
#pragma unroll
        for (int ai = 0; ai < 2; ++ai)
#pragma unroll
            for (int m = 0; m < 4; ++m) {
                float ss = 0.f;
#pragma unroll
                for (int bj = 0; bj < 2; ++bj)
#pragma unroll
                    for (int n = 0; n < 2; ++n) { const f32x4 v = acc[ai][bj][m][n]; ss += (v[0] * v[0] + v[1] * v[1]) + (v[2] * v[2] + v[3] * v[3]); }
                ss += __shfl_xor(ss, 16); ss += __shfl_xor(ss, 32);
                const float rstd = rsqrtf(ss * (1.0f / 64.0f) + EPS);
                const int row = u.pm * 256 + ai * 128 + wr * 64 + m * 16 + fr;
                bf16* p = base + (size_t)row * 512 + head * 64 + 8 * fq;
#pragma unroll
                for (int bj = 0; bj < 2; ++bj) {
                    const f32x4 v0 = acc[ai][bj][m][0] * gv[bj][0] * rstd, v1 = acc[ai][bj][m][1] * gv[bj][1] * rstd;
                    v4u w; w.x = cvt_pk_bf16(v0[0], v0[1]); w.y = cvt_pk_bf16(v0[2], v0[3]); w.z = cvt_pk_bf16(v1[0], v1[1]); w.w = cvt_pk_bf16(v1[2], v1[3]);
                    *(v4u*)(p + 32 * bj) = w;
                }
            }
    }
};
template <int T1> struct EpiU {
    static constexpr bool MIDK = false; static constexpr bool PERM = true, AFTER_DRAIN = false;
    bf16* UT;
    __device__ __forceinline__ void operator()(const f32x4 (&acc)[2][2][4][2], const Unit& u, int wr, int wc, int fr, int fq) const {
#pragma unroll
        for (int ai = 0; ai < 2; ++ai)
#pragma unroll
            for (int m = 0; m < 4; ++m) {
                const int cp = u.pm * 256 + ai * 128 + wr * 64 + m * 16 + fr, cs = cp >> 9, ch = cp & 511;
#pragma unroll
                for (int bj = 0; bj < 2; ++bj) {
                    const int nb = u.pn * 256 + bj * 128 + wc * 32 + 8 * fq;
                    size_t addr;
                    if (T1 == 128) { const int sq = nb >> 13, nl = nb & 8191, t2 = nl >> 7, t1 = nl & 127; addr = ((size_t)((sq * 512 + ch) * 64 + t2)) * 256 + cs * 128 + t1; }
                    else { const int sq = nb >> 12, nl = nb & 4095, t2 = nl >> 6, t1 = nl & 63; addr = ((size_t)((sq * 512 + ch) * 64 + t2)) * 128 + cs * 64 + t1; }
                    const f32x4 v0 = acc[ai][bj][m][0], v1 = acc[ai][bj][m][1];
                    v4u w; w.x = cvt_pk_bf16(v0[0], v0[1]); w.y = cvt_pk_bf16(v0[2], v0[3]); w.z = cvt_pk_bf16(v1[0], v1[1]); w.w = cvt_pk_bf16(v1[2], v1[3]);
                    *(v4u*)(UT + addr) = w;
                }
            }
    }
};
struct EpiV {
    static constexpr bool MIDK = false; static constexpr bool PERM = true, AFTER_DRAIN = false;
    unsigned char* ws;
    __device__ __forceinline__ void operator()(const f32x4 (&acc)[2][2][4][2], const Unit& u, int wr, int wc, int fr, int fq) const {
        const int tokt = u.pn * 256; const bool isP = tokt < NTOK_P;
        int b, t0, T;
        if (isP) { b = tokt >> 12; t0 = tokt & 4095; T = TP; } else { const int tt = tokt - NTOK_P; b = tt >> 13; t0 = tt & 8191; T = TS; }
        bf16* dst = (bf16*)(ws + (isP ? WS_VTP : WS_VTS));
        const int rowbase = b * 512 + u.pm * 256;
#pragma unroll
        for (int ai = 0; ai < 2; ++ai)
#pragma unroll
            for (int m = 0; m < 4; ++m) {
                const int r = rowbase + ai * 128 + wr * 64 + m * 16 + fr;
                bf16* p = dst + (size_t)r * T + t0 + wc * 32 + 8 * fq;
#pragma unroll
                for (int bj = 0; bj < 2; ++bj) {
                    const f32x4 v0 = acc[ai][bj][m][0], v1 = acc[ai][bj][m][1];
                    v4u w; w.x = cvt_pk_bf16(v0[0], v0[1]); w.y = cvt_pk_bf16(v0[2], v0[3]); w.z = cvt_pk_bf16(v1[0], v1[1]); w.w = cvt_pk_bf16(v1[2], v1[3]);
                    *(v4u*)(p + 128 * bj) = w;
                }
            }
    }
};
template <int T1> struct EpiA {
    static constexpr bool MIDK = false; static constexpr bool PERM = true, AFTER_DRAIN = false;
    bf16* Y;
    __device__ __forceinline__ void operator()(const f32x4 (&acc)[2][2][4][2], const Unit& u, int wr, int wc, int fr, int fq) const {
        if (T1 == 64 && wr != 0) return;
#pragma unroll
        for (int m = 0; m < 4; ++m) {
            const int k1 = (T1 == 128 ? 64 * wr : 0) + 16 * m + fr;
#pragma unroll
            for (int bj = 0; bj < 2; ++bj) {
                const int nb = u.pn * 256 + bj * 128 + wc * 32 + 8 * fq, sq = nb >> 15, ch = (nb >> 6) & 511, t2b = nb & 63;
                bf16* p = Y + ((size_t)((sq * T1 + k1) * 512 + ch)) * 128 + t2b;
#pragma unroll
                for (int ri = 0; ri < 2; ++ri) {
                    const f32x4 v0 = acc[ri][bj][m][0], v1 = acc[ri][bj][m][1];
                    v4u w; w.x = cvt_pk_bf16(v0[0], v0[1]); w.y = cvt_pk_bf16(v0[2], v0[3]); w.z = cvt_pk_bf16(v1[0], v1[1]); w.w = cvt_pk_bf16(v1[2], v1[3]);
                    *(v4u*)(p + 64 * ri) = w;
                }
            }
        }
    }
};
template <int T1> struct EpiB {
    static constexpr bool MIDK = false; static constexpr bool PERM = true, AFTER_DRAIN = false;
    bf16* CAT; float* ssqf; int tokbase;
    __device__ __forceinline__ void operator()(const f32x4 (&acc)[2][2][4][2], const Unit& u, int wr, int wc, int fr, int fq) const {
        if (wr != 0) return;
        const int sk1 = u.pn >> 1, sq = sk1 / T1, k1 = sk1 % T1;
#pragma unroll
        for (int m = 0; m < 4; ++m) {
            const int k2 = 16 * m + fr, tok = tokbase + sq * (64 * T1) + k1 + T1 * k2;
            float ss = 0.f;
#pragma unroll
            for (int bj = 0; bj < 2; ++bj) {
                const int ch = (u.pn & 1) * 256 + bj * 128 + wc * 32 + 8 * fq;
                const f32x4 v0 = acc[0][bj][m][0], v1 = acc[0][bj][m][1];
                ss += (v0[0] * v0[0] + v0[1] * v0[1]) + (v0[2] * v0[2] + v0[3] * v0[3]) + (v1[0] * v1[0] + v1[1] * v1[1]) + (v1[2] * v1[2] + v1[3] * v1[3]);
                v4u w; w.x = cvt_pk_bf16(v0[0], v0[1]); w.y = cvt_pk_bf16(v0[2], v0[3]); w.z = cvt_pk_bf16(v1[0], v1[1]); w.w = cvt_pk_bf16(v1[2], v1[3]);
                *(v4u*)(CAT + (size_t)tok * 1024 + ch) = w;
            }
            ss += __shfl_xor(ss, 16); ss += __shfl_xor(ss, 32);
            if (fq == 0) unsafeAtomicAdd(ssqf + tok, ss);
        }
    }
};
struct EpiWo {
    static constexpr bool MIDK = true; static constexpr int MIDT = 8;
    static constexpr bool PERM = true, AFTER_DRAIN = false;
    const float* xp; const float* xs; bf16* XB; const float* mod; float* ssq; const LAS float* rs;
    __device__ __forceinline__ void mid(f32x4 (&acc)[2][2][4][2], int ui, int wr, int wc, int fr, int fq) const {
#pragma unroll
        for (int ai = 0; ai < 2; ++ai)
#pragma unroll
            for (int m = 0; m < 4; ++m) {
                const float ratio = rs[ui * 512 + 2 * (ai * 128 + wr * 64 + m * 16 + fr)];
#pragma unroll
                for (int bj = 0; bj < 2; ++bj)
#pragma unroll
                    for (int n = 0; n < 2; ++n) acc[ai][bj][m][n] *= ratio;
            }
    }
    __device__ __forceinline__ void fin(const f32x4 (&acc)[2][2][4][2], const Unit& u, int ui, int wr, int wc, int fr, int fq) const {
        const int tokt = u.pm * 256, b = batch_of(tokt);
        const float* xb = tokt < NTOK_P ? xp + (size_t)tokt * D : xs + (size_t)(tokt - NTOK_P) * D;
        const int col0 = u.pn * 256 + wc * 32 + 8 * fq;
        const float* gp = mod + b * NMOD + 2048 + col0;
        bf16* xbo = XB + (size_t)tokt * D;
#pragma unroll
        for (int ai = 0; ai < 2; ++ai)
#pragma unroll
            for (int m = 0; m < 4; ++m) {
                const int rl = ai * 128 + wr * 64 + m * 16 + fr; float ss = 0.f;
                const float ra = rs[ui * 512 + 2 * rl + 1];
#pragma unroll
                for (int bj = 0; bj < 2; ++bj) {
                    asm volatile("" ::: "memory");
                    const unsigned off = (unsigned)(rl * D + col0 + bj * 128);
                    const f32x4 g0 = *(const f32x4*)(gp + bj * 128), g1 = *(const f32x4*)(gp + bj * 128 + 4);
                    const f32x4 o0 = *(const f32x4*)(xb + off) + g0 * (acc[ai][bj][m][0] * ra), o1 = *(const f32x4*)(xb + off + 4) + g1 * (acc[ai][bj][m][1] * ra);
                    ss += (o0[0] * o0[0] + o0[1] * o0[1]) + (o0[2] * o0[2] + o0[3] * o0[3]) + (o1[0] * o1[0] + o1[1] * o1[1]) + (o1[2] * o1[2] + o1[3] * o1[3]);
                    v4u w; w.x = cvt_pk_bf16(o0[0], o0[1]); w.y = cvt_pk_bf16(o0[2], o0[3]); w.z = cvt_pk_bf16(o1[0], o1[1]); w.w = cvt_pk_bf16(o1[2], o1[3]);
                    *(v4u*)(xbo + off) = w;
                }
                ss += __shfl_xor(ss, 16); ss += __shfl_xor(ss, 32);
                if (fq == 0) unsafeAtomicAdd(ssq + tokt + rl, ss);
            }
    }
};
struct EpiUp {
    static constexpr bool MIDK = false; static constexpr bool PERM = true, AFTER_DRAIN = false;
    bf16* HID;
    __device__ __forceinline__ void operator()(const f32x4 (&acc)[2][2][4][2], const Unit& u, int wr, int wc, int fr, int fq) const {
#pragma unroll
        for (int ai = 0; ai < 2; ++ai)
#pragma unroll
            for (int m = 0; m < 4; ++m) {
                const int row = u.pm * 256 + ai * 128 + wr * 64 + m * 16 + fr;
                bf16* p = HID + (size_t)row * DFF + u.pn * 128 + wc * 32 + 8 * fq;
                float v[8];
#pragma unroll
                for (int n = 0; n < 2; ++n)
#pragma unroll
                    for (int i = 0; i < 4; ++i) { const float g = acc[ai][0][m][n][i], up = acc[ai][1][m][n][i]; v[4 * n + i] = g * __builtin_amdgcn_rcpf(1.0f + __expf(-g)) * up; }
                v4u w; w.x = cvt_pk_bf16(v[0], v[1]); w.y = cvt_pk_bf16(v[2], v[3]); w.z = cvt_pk_bf16(v[4], v[5]); w.w = cvt_pk_bf16(v[6], v[7]);
                *(v4u*)p = w;
            }
    }
};
struct EpiDown {
    static constexpr bool MIDK = false; static constexpr bool PERM = false, AFTER_DRAIN = false;
    float* out; const bf16* XB; const float* mod;
    __device__ __forceinline__ void operator()(const f32x4 (&acc)[2][2][4][2], const Unit& u, int wr, int wc, int fr, int fq) const {
        const int tokt = u.pm * 256, b = batch_of(tokt);
        const int col0 = u.pn * 256 + wc * 32 + 4 * fq;
        f32x4 gt[2][2];
#pragma unroll
        for (int bj = 0; bj < 2; ++bj)
#pragma unroll
            for (int n = 0; n < 2; ++n) gt[bj][n] = *(const f32x4*)(mod + b * NMOD + 5120 + col0 + bj * 128 + n * 16);
#pragma unroll
        for (int ai = 0; ai < 2; ++ai)
#pragma unroll
            for (int m = 0; m < 4; ++m) {
                const int rl = ai * 128 + wr * 64 + m * 16 + fr;
#pragma unroll
                for (int bj = 0; bj < 2; ++bj)
#pragma unroll
                    for (int n = 0; n < 2; ++n) {
                        const size_t off = (size_t)(tokt + rl) * D + col0 + bj * 128 + n * 16;
                        const v2u xw = *(const v2u*)(XB + off);
                        const f32x4 x1 = {bf_lo(xw.x), bf_hi(xw.x), bf_lo(xw.y), bf_hi(xw.y)};
                        *(f32x4*)(out + off) = x1 + gt[bj][n] * acc[ai][bj][m][n];
                    }
            }
    }
};

__device__ __forceinline__ int rowmap(int kind, int n) {
    switch (kind) {
        case 1: return (n & ~255) + 128 * ((n >> 5) & 1) + 32 * ((n >> 6) & 3) + (n & 31);
        case 2: return 256 * (n >> 7) + (n & 127);
        case 3: return 256 * (n >> 7) + 128 + (n & 127);
        case 4: return 1024 + n;
        default: return n;
    }
}
__device__ __forceinline__ void tr_item(const float* W, int ldw, int col0, int K, bf16* WT, int kind, int nblk, LAS float* scr, int item, int lane, const float* ks0 = nullptr, const float* ks1 = nullptr) {
    const int kb = item / nblk, nb = item % nblk, k0 = 64 * kb, n0 = 32 * nb;
    const float* ks = ks0 ? (k0 < 512 ? ks0 + k0 : ks1 + (k0 - 512)) : nullptr;
#pragma unroll 8
    for (int i = 0; i < 32; ++i) { const int kk = 2 * i + (lane >> 5); scr[kk * 33 + (lane & 31)] = W[(size_t)(k0 + kk) * ldw + col0 + n0 + (lane & 31)] * (ks ? ks[kk] : 1.0f); }
    asm volatile("s_waitcnt lgkmcnt(0)" ::: "memory");
    const int c = lane & 7;
#pragma unroll
    for (int j = 0; j < 4; ++j) {
        const int n = (lane >> 3) + 8 * j; const LAS float* s = scr + (8 * c) * 33 + n;
        v4u o; o.x = cvt_pk_bf16(s[0 * 33], s[1 * 33]); o.y = cvt_pk_bf16(s[2 * 33], s[3 * 33]); o.z = cvt_pk_bf16(s[4 * 33], s[5 * 33]); o.w = cvt_pk_bf16(s[6 * 33], s[7 * 33]);
        *(v4u*)(WT + (size_t)rowmap(kind, n0 + n) * K + k0 + 8 * c) = o;
    }
    asm volatile("s_waitcnt lgkmcnt(0)" ::: "memory");
}

__device__ __forceinline__ void phase0(const Args& a, LAS unsigned char* lds, int tid, int lane, int wave, int bid, int G) {
    unsigned char* ws = a.ws;
    float* mod = (float*)(ws + WS_MOD);
    for (int task = bid; task < NMOD / 64; task += G) {
        LAS float* sc = (LAS float*)lds;
        LAS float* red = (LAS float*)(lds + 49152);
        for (int u = tid; u < 12 * 1024; u += 512) { const int b = u >> 10, i = u & 1023; const float c = b < 4 ? a.cp[b * 1024 + i] : a.cs[(b - 4) * 1024 + i]; sc[u] = c / (1.0f + __expf(-c)); }
        __syncthreads();
        const int j0 = task * 64;
        float acc[12];
#pragma unroll
        for (int b = 0; b < 12; ++b) acc[b] = 0.f;
        for (int ii = 0; ii < 128; ++ii) {
            const int i = wave * 128 + ii; const float w = a.w_ada[(size_t)i * NMOD + j0 + lane];
#pragma unroll
            for (int b = 0; b < 12; ++b) acc[b] += sc[b * 1024 + i] * w;
        }
#pragma unroll
        for (int b = 0; b < 12; ++b) red[(wave * 12 + b) * 64 + lane] = acc[b];
        __syncthreads();
        for (int u = tid; u < 768; u += 512) {
            const int b = u >> 6, col = u & 63; float s = a.b_ada[j0 + col];
#pragma unroll
            for (int w = 0; w < 8; ++w) s += red[(w * 12 + b) * 64 + col];
            mod[b * NMOD + j0 + col] = s;
        }
        __syncthreads();
    }
    {
        LAS float* scr = (LAS float*)(lds + wave * 16384);
        const int gw = bid * 8 + wave, NGW = G * 8;
        constexpr int I_QK = 16 * 32, I_V = 16 * 16, I_O = 16 * 32, I_G = 16 * 88, I_D = 44 * 32;
        constexpr int NITEMS = I_QK + I_V + I_O + 2 * I_G + I_D;
        for (int it = gw; it < NITEMS; it += NGW) {
            int r = it;
            if (r < I_QK) { tr_item(a.w_in, 2048, 512, 1024, (bf16*)(ws + WS_WQK), 1, 32, scr, r, lane); continue; } r -= I_QK;
            if (r < I_V) { tr_item(a.w_in, 2048, 1536, 1024, (bf16*)(ws + WS_WUV), 4, 16, scr, r, lane); continue; } r -= I_V;
            if (r < I_O) { tr_item(a.w_o, 1024, 0, 1024, (bf16*)(ws + WS_WO), 0, 32, scr, r, lane, a.g_fout, a.g_aout); continue; } r -= I_O;
            if (r < I_G) { tr_item(a.w_gate, DFF, 0, 1024, (bf16*)(ws + WS_WGU), 2, 88, scr, r, lane); continue; } r -= I_G;
            if (r < I_G) { tr_item(a.w_up, DFF, 0, 1024, (bf16*)(ws + WS_WGU), 3, 88, scr, r, lane); continue; } r -= I_G;
            tr_item(a.w_down, 1024, 0, DFF, (bf16*)(ws + WS_WD), 0, 32, scr, r, lane);
        }
    }
    {
        float* CS = (float*)(ws + WS_CS);
        for (int o = bid * 512 + tid; o < 2 * 4 * 128 * 128; o += G * 512) {
            const int d = o & 127, c = (o >> 7) & 127, g = (o >> 14) & 3, cs = o >> 16;
            float s = 0.f;
            for (int e = 0; e < 128; ++e) {
                const float ang = (float)((c * e) & 127) * (1.0f / 128.0f);
                const float t = cs ? __builtin_amdgcn_sinf(ang) : __builtin_amdgcn_cosf(ang);
                s += t * a.w_fmix[(g * 128 + e) * 128 + d];
            }
            CS[o] = s * 0.08838834764831845f;
        }
    }
    {
        bf16* DAS = (bf16*)(ws + WS_DAS); bf16* DAP = (bf16*)(ws + WS_DAP);
        for (int o = bid * 512 + tid; o < 65536 + 32768; o += G * 512) {
            float v = 0.f; bf16* dst;
            if (o < 65536) {
                const int r = o >> 8, k = o & 255, ri = r >> 7, k1 = r & 127, cs = k >> 7, t1 = k & 127;
                const float f = (float)((k1 * t1) & 127) * (1.0f / 128.0f), c = __builtin_amdgcn_cosf(f), sn = __builtin_amdgcn_sinf(f);
                v = (ri == 0 ? (cs == 0 ? c : -sn) : (cs == 0 ? -sn : -c)) * 0.08838834764831845f; dst = DAS + o;
            } else {
                const int o2 = o - 65536, r = o2 >> 7, k = o2 & 127, ri = r >> 7, rr = r & 127, cs = k >> 6, t1 = k & 63;
                if (rr < 64) { const float f = (float)((rr * t1) & 63) * (1.0f / 64.0f), c = __builtin_amdgcn_cosf(f), sn = __builtin_amdgcn_sinf(f);
                    v = (ri == 0 ? (cs == 0 ? c : -sn) : (cs == 0 ? -sn : -c)) * 0.125f; }
                dst = DAP + o2;
            }
            *dst = (bf16)(cvt_pk_bf16(v, 0.f) & 0xffffu);
        }
        for (int it = bid * 512 + tid; it < (128 + 64) * 256 * 16; it += G * 512) {
            const bool isS = it < 128 * 256 * 16; const int i2 = isS ? it : it - 128 * 256 * 16;
            const int row = i2 >> 4, k0 = (i2 & 15) * 8, k1 = row >> 8, r = row & 255, ri = k0 >> 6, t2 = k0 & 63;
            const int T1 = isS ? 128 : 64, T = 64 * T1, kk = k1 + T1 * r;
            float v[8];
#pragma unroll
            for (int e = 0; e < 8; ++e) { const float f = (float)((kk * (t2 + e)) & (T - 1)) * (1.0f / (float)T); v[e] = r < 64 ? (ri == 0 ? __builtin_amdgcn_cosf(f) : __builtin_amdgcn_sinf(f)) * 0.125f : 0.f; }
            v4u w; w.x = cvt_pk_bf16(v[0], v[1]); w.y = cvt_pk_bf16(v[2], v[3]); w.z = cvt_pk_bf16(v[4], v[5]); w.w = cvt_pk_bf16(v[6], v[7]);
            *(v4u*)((bf16*)(ws + (isS ? WS_DBS : WS_DBP)) + (size_t)row * 128 + k0) = w;
        }
    }
}

template <bool FROM_SSQ>
__device__ __forceinline__ void norm_rows(const Args& a, const float* xsrc_p, const float* xsrc_s, const float* g, int shift_off, int scale_off, const float* ssq, bf16* H, int lane, int gw, int NGW) {
    const float* mod = (const float*)(a.ws + WS_MOD);
    for (int ch = gw; ch < NTOK / 8; ch += NGW) {
        const int tok0 = ch * 8, b = batch_of(tok0);
        const float* mb = mod + b * NMOD;
        f32x4 gs[4], sh[4];
#pragma unroll
        for (int jj = 0; jj < 4; ++jj) {
            const int c = lane * 4 + 256 * jj;
            gs[jj] = *(const f32x4*)(g + c) * (*(const f32x4*)(mb + scale_off + c) + 1.0f);
            sh[jj] = *(const f32x4*)(mb + shift_off + c);
        }
        for (int tt = 0; tt < 8; ++tt) {
            const int tok = tok0 + tt;
            const float* xr = tok < NTOK_P ? xsrc_p + (size_t)tok * D : xsrc_s + (size_t)(tok - NTOK_P) * D;
            f32x4 v[4]; float ss = 0.f;
#pragma unroll
            for (int jj = 0; jj < 4; ++jj) { if (FROM_SSQ) { const v2u xw = *(const v2u*)((const bf16*)xsrc_p + (size_t)tok * D + lane * 4 + 256 * jj); v[jj] = (f32x4){bf_lo(xw.x), bf_hi(xw.x), bf_lo(xw.y), bf_hi(xw.y)}; } else v[jj] = *(const f32x4*)(xr + lane * 4 + 256 * jj); ss += (v[jj][0] * v[jj][0] + v[jj][1] * v[jj][1]) + (v[jj][2] * v[jj][2] + v[jj][3] * v[jj][3]); }
            float tot;
            if (FROM_SSQ) tot = ssq[tok]; else tot = wave_sum(ss);
            const float rstd = rsqrtf(tot * (1.0f / 1024.0f) + EPS);
#pragma unroll
            for (int jj = 0; jj < 4; ++jj) {
                const f32x4 o = v[jj] * rstd * gs[jj] + sh[jj];
                v2u w; w.x = cvt_pk_bf16(o[0], o[1]); w.y = cvt_pk_bf16(o[2], o[3]);
                *(v2u*)(H + (size_t)tok * D + lane * 4 + 256 * jj) = w;
            }
        }
    }
}

__device__ __forceinline__ void fold_uw(const Args& a, LAS unsigned char* lds, int tid, int bid, int G) {
    const float* CS = (const float*)(a.ws + WS_CS);
    bf16* WUV = (bf16*)(a.ws + WS_WUV);
    LAS float* Wt = (LAS float*)lds;
    LAS float* CSl = (LAS float*)(lds + 16384);
    for (int task = bid; task < 256; task += G) {
        const int cs = task >> 7, g = (task >> 5) & 3, i0 = (task & 31) * 32;
        for (int u = tid; u < 32 * 128; u += 512) { const int i = u >> 7, c = u & 127; Wt[u] = a.w_in[(size_t)(i0 + i) * 2048 + g * 128 + c]; }
        for (int u = tid; u < 128 * 128; u += 512) CSl[u] = CS[(size_t)(cs * 4 + g) * 16384 + u];
        __syncthreads();
        const int d = tid & 127, iq = tid >> 7;
        float acc[8];
#pragma unroll
        for (int ii = 0; ii < 8; ++ii) acc[ii] = 0.f;
        for (int c = 0; c < 128; ++c) {
            const float csv = CSl[c * 128 + d];
#pragma unroll
            for (int ii = 0; ii < 8; ++ii) acc[ii] += Wt[(iq * 8 + ii) * 128 + c] * csv;
        }
        v4u w; w.x = cvt_pk_bf16(acc[0], acc[1]); w.y = cvt_pk_bf16(acc[2], acc[3]); w.z = cvt_pk_bf16(acc[4], acc[5]); w.w = cvt_pk_bf16(acc[6], acc[7]);
        *(v4u*)(WUV + (size_t)(cs * 512 + g * 128 + d) * 1024 + i0 + iq * 8) = w;
        __syncthreads();
    }
}

constexpr int AT_ROWB = 144, AT_SLOT = 2 * 64 * AT_ROWB;
constexpr int AT_RPB_OFF = 40960, AT_SMAX_OFF = AT_RPB_OFF + 8 * 480 * 4;
__device__ __forceinline__ void attn_task(const Args& a, int task, LAS unsigned char* lds, int tid, int wave, int lane, const unsigned (&idxp)[4], const int mbits) {
    const bf16* Q = (const bf16*)(a.ws + WS_Q); const bf16* K = (const bf16*)(a.ws + WS_K); bf16* CAT = (bf16*)(a.ws + WS_CAT);
    float* ssqa = (float*)(a.ws + WS_SSQA);
    int h, i0, T, tok0, rows; const bf16* vt;
    if (task < 256) { const int seq = task >> 6; h = (task >> 3) & 7; i0 = (task & 7) * 8; T = TP; tok0 = seq * TP; rows = 64; vt = (const bf16*)(a.ws + WS_VTP) + (size_t)seq * 512 * TP; }
    else { const int t2 = task - 256, seq = t2 >> 7; h = (t2 >> 4) & 7; i0 = (t2 & 15) * 8; T = TS; tok0 = NTOK_P + seq * TS; rows = 128; vt = (const bf16*)(a.ws + WS_VTS) + (size_t)seq * 512 * TS; }
    const int q = lane & 15, g = lane >> 4, i = i0 + wave;
    const int rsw = min(max(i - 4, 0), rows - 8);
    const int kr_lo = min(max(i0 - 4, 0), rows - 8), kr_hi = min(max(i0 + 3, 0), rows - 8) + 7;
    const LAS unsigned char* tabh = lds + AT_RPB_OFF + h * 1920;
    const bf16* kg = K + (size_t)(tok0 + (tid >> 3)) * 512 + 64 * h + (tid & 7) * 8;
    const bf16* vg = vt + (size_t)(64 * h + (tid >> 3)) * T + (tid & 7) * 8;
    const int stoff = (tid >> 3) * AT_ROWB + (tid & 7) * 16;
    v4u kst[2], vst[2];
#pragma unroll
    for (int u = 0; u < 2; ++u) if (kr_lo + u <= kr_hi) { kst[u] = *(const v4u*)(kg + (size_t)(kr_lo + u) * 64 * 512); vst[u] = *(const v4u*)(vg + (kr_lo + u) * 64); }
    bf16x8 bq[4][2];
#pragma unroll
    for (int j = 0; j < 4; ++j) { const bf16* qp = Q + (size_t)(tok0 + i * 64 + 16 * j + q) * 512 + 64 * h + 8 * g; bq[j][0] = *(const bf16x8*)qp; bq[j][1] = *(const bf16x8*)(qp + 32); }
    f32x4 O[4][4]; float sum[4];
#pragma unroll
    for (int j = 0; j < 4; ++j) { sum[j] = 0.f;
#pragma unroll
        for (int db = 0; db < 4; ++db) O[j][db] = (f32x4){0.f, 0.f, 0.f, 0.f}; }
    *(LAS v4u*)(lds + (kr_lo & 1) * AT_SLOT + stoff) = kst[0]; *(LAS v4u*)(lds + (kr_lo & 1) * AT_SLOT + 64 * AT_ROWB + stoff) = vst[0];
    __syncthreads();
    for (int base = kr_lo; base <= kr_hi; base += 2) {
#pragma unroll
      for (int u = 0; u < 2; ++u) {
        const int kr = base + u;
        if (kr > kr_hi) break;
        if (kr + 2 <= kr_hi) { kst[u] = *(const v4u*)(kg + (size_t)(kr + 2) * 64 * 512); vst[u] = *(const v4u*)(vg + (kr + 2) * 64); }
        if (kr >= rsw && kr < rsw + 8) {
            const LAS unsigned char* Ks = lds + (kr & 1) * AT_SLOT; const LAS unsigned char* Vs = Ks + 64 * AT_ROWB;
            const LAS unsigned char* rb = tabh + (kr - i + 7) * 128;
            bf16x8 kf[2][4]; float tbv[2][4];
#define AT_LOADK(j_, buf_) do { const int kc0_ = ((j_) == 0) ? 0 : ((j_) == 1) ? 8 : ((j_) == 2) ? 24 : 32; \
                _Pragma("unroll") for (int cb = 0; cb < 2; ++cb) { const LAS unsigned char* kp = Ks + (kc0_ + 16 * cb + q) * AT_ROWB + 16 * g; \
                    kf[buf_][2 * cb] = *(const LAS bf16x8*)kp; kf[buf_][2 * cb + 1] = *(const LAS bf16x8*)(kp + 64); } \
                _Pragma("unroll") for (int e = 0; e < 4; ++e) tbv[buf_][e] = *(const LAS float*)(rb + ((idxp[j_] >> (8 * e)) & 0xffu)); } while (0)
            AT_LOADK(0, 0);
#pragma unroll
            for (int j = 0; j < 4; ++j) {
                const int kc0 = (j == 0) ? 0 : (j == 1) ? 8 : (j == 2) ? 24 : 32;
                const int cur = j & 1;
                v2u vlo[4], vhi[4];
#pragma unroll
                for (int db = 0; db < 4; ++db) { const LAS unsigned char* vp = Vs + (16 * db + q) * AT_ROWB + (kc0 + 4 * g) * 2; vlo[db] = *(const LAS v2u*)vp; vhi[db] = *(const LAS v2u*)(vp + 32); }
                if (j < 3) AT_LOADK(j + 1, cur ^ 1);
                __builtin_amdgcn_sched_barrier(0);
                f32x4 sv[2];
                __builtin_amdgcn_s_setprio(1);
#pragma unroll
                for (int cb = 0; cb < 2; ++cb) {
                    f32x4 z = {0.f, 0.f, 0.f, 0.f};
                    z = __builtin_amdgcn_mfma_f32_16x16x32_bf16(kf[cur][2 * cb], bq[j][0], z, 0, 0, 0);
                    z = __builtin_amdgcn_mfma_f32_16x16x32_bf16(kf[cur][2 * cb + 1], bq[j][1], z, 0, 0, 0);
                    sv[cb] = z;
                }
                __builtin_amdgcn_s_setprio(0);
                float ps = 0.f;
#pragma unroll
                for (int e = 0; e < 4; ++e) {
                    const bool v0 = (mbits >> (j * 4 + e)) & 1;
                    const float p = __builtin_amdgcn_exp2f((v0 ? sv[0][e] : sv[1][e]) + tbv[cur][e]);
                    sv[0][e] = v0 ? p : 0.f; sv[1][e] = v0 ? 0.f : p; ps += p;
                }
                sum[j] += ps;
                v4u pw; pw.x = cvt_pk_bf16(sv[0][0], sv[0][1]); pw.y = cvt_pk_bf16(sv[0][2], sv[0][3]); pw.z = cvt_pk_bf16(sv[1][0], sv[1][1]); pw.w = cvt_pk_bf16(sv[1][2], sv[1][3]);
                const bf16x8 pf = __builtin_bit_cast(bf16x8, pw);
                __builtin_amdgcn_s_setprio(1);
#pragma unroll
                for (int db = 0; db < 4; ++db) {
                    v4u w; w.x = vlo[db].x; w.y = vlo[db].y; w.z = vhi[db].x; w.w = vhi[db].y;
                    O[j][db] = __builtin_amdgcn_mfma_f32_16x16x32_bf16(__builtin_bit_cast(bf16x8, w), pf, O[j][db], 0, 0, 0);
                }
                __builtin_amdgcn_s_setprio(0);
            }
#undef AT_LOADK
        }
        if (kr < kr_hi) { *(LAS v4u*)(lds + ((kr + 1) & 1) * AT_SLOT + stoff) = kst[(u + 1) & 1]; *(LAS v4u*)(lds + ((kr + 1) & 1) * AT_SLOT + 64 * AT_ROWB + stoff) = vst[(u + 1) & 1]; }
        __syncthreads();
      }
    }
#pragma unroll
    for (int j = 0; j < 4; ++j) {
        float sm = sum[j]; sm += __shfl_xor(sm, 16); sm += __shfl_xor(sm, 32);
        const float inv = 1.0f / sm; float ss = 0.f;
        const int tok = tok0 + i * 64 + 16 * j + q;
        bf16* op = CAT + (size_t)tok * 1024 + 512 + 64 * h + 4 * g;
#pragma unroll
        for (int db = 0; db < 4; ++db) {
            const f32x4 o = O[j][db] * inv;
            ss += (o[0] * o[0] + o[1] * o[1]) + (o[2] * o[2] + o[3] * o[3]);
            v2u w; w.x = cvt_pk_bf16(o[0], o[1]); w.y = cvt_pk_bf16(o[2], o[3]);
            *(v2u*)(op + 16 * db) = w;
        }
        ss += __shfl_xor(ss, 16); ss += __shfl_xor(ss, 32);
        if (g == 0) unsafeAtomicAdd(ssqa + tok, ss);
    }
}

__device__ __forceinline__ void attn_phase(const Args& a, LAS unsigned char* lds, int tid, int lane, int wave, int bid, int G, int part_lo, int part_hi) {
    {
        LAS float* tb = (LAS float*)(lds + AT_RPB_OFF) + wave * 480;
        float mb = 0.f;
        for (int idx = lane; idx < 465; idx += 64) mb = fmaxf(mb, fabsf(a.rpb[wave * 465 + idx]));
        float mq = fabsf(a.g_q[lane]), mk = fabsf(a.g_k[lane]);
#pragma unroll
        for (int o = 1; o < 64; o <<= 1) { mb = fmaxf(mb, __shfl_xor(mb, o)); mq = fmaxf(mq, __shfl_xor(mq, o)); mk = fmaxf(mk, __shfl_xor(mk, o)); }
        const float smax = 8.0f * mq * mk + mb;
        for (int idx = lane; idx < 480; idx += 64) { const int dr = idx >> 5, dc = idx & 31; tb[idx] = dc < 31 ? (a.rpb[wave * 465 + dr * 31 + dc] - smax) * 1.4426950408889634f : -1e30f; }
    }
    int mbits = 0;
    unsigned idxp[4];
    {
        const int q = lane & 15, g = lane >> 4;
#pragma unroll
        for (int j = 0; j < 4; ++j) {
            const int kc0 = (j == 0) ? 0 : (j == 1) ? 8 : (j == 2) ? 24 : 32;
            const int c = 16 * j + q, cst = min(max(c - 8, 0), 48);
            unsigned pk = 0u;
#pragma unroll
            for (int e = 0; e < 4; ++e) {
                const int k0c = kc0 + 4 * g + e, k1c = k0c + 16; const bool ok0 = (unsigned)(k0c - cst) < 16u;
                pk |= (unsigned)(((ok0 ? k0c : k1c) - c + 15) * 4) << (8 * e); mbits |= (ok0 ? 1 : 0) << (j * 4 + e);
            }
            idxp[j] = pk;
        }
    }
    __syncthreads();
    const int per = (1280 + G - 1) / G, r0 = bid * per, r1 = min(1280, r0 + per);
    for (int t = r0 + part_lo; t < min(r1, r0 + part_hi); ++t) attn_task(a, t, lds, tid, wave, lane, idxp, mbits);
    __syncthreads();
}

#define XB_TMO      128
#define XB_XCNT(j)  (256  + 64 * (j))
#define XB_XSUB(j)  (1280 + 64 * (j))
#define XB_XGEN(j)  (2304 + 64 * (j))
#define XB_TOP      3328
#define XB_TOPGEN   3392
#define XCD_BAR_WORDS 3456
#define XB_SPIN_CAP (1u << 18)

__device__ __forceinline__ unsigned xb_ld(unsigned* p)              { return __hip_atomic_load(p, __ATOMIC_RELAXED, __HIP_MEMORY_SCOPE_AGENT); }
__device__ __forceinline__ unsigned xb_add(unsigned* p, unsigned v) { return __hip_atomic_fetch_add(p, v, __ATOMIC_RELAXED, __HIP_MEMORY_SCOPE_AGENT); }
__device__ __forceinline__ unsigned xb_xcc_id() { return (unsigned)__builtin_amdgcn_s_getreg((3 << 11) | 20) & 0xFu; }
#define XB_SPIN(cond, bar) do { unsigned _sp = 0; while (cond) { __builtin_amdgcn_s_sleep(1); \
    if ((++_sp & 255u) == 0u) { if (xb_ld(&(bar)[XB_TMO])) break; if (_sp > XB_SPIN_CAP) { atomicAdd(&(bar)[XB_TMO], 1u); break; } } } } while (0)

struct XcdBarrier {
    unsigned* bar; unsigned x;
    volatile LAS unsigned* st;
};

__device__ __forceinline__ XcdBarrier xcd_barrier_post(unsigned* bar, volatile LAS unsigned* st) {
    XcdBarrier b; b.bar = bar; b.x = xb_xcc_id(); b.st = st;
    if (threadIdx.x == 0) (void)xb_add(&bar[XB_XCNT(b.x)], 1u);
    return b;
}
__device__ __forceinline__ void xcd_barrier_complete(unsigned* bar, unsigned x, unsigned& nloc, unsigned& nx) {
    const unsigned G = gridDim.x * gridDim.y * gridDim.z;
    unsigned sum, cnt, mine, sp = 0u;
    for (;;) {
        sum = 0u; cnt = 0u; mine = 0u;
#pragma unroll
        for (unsigned j = 0; j < 16; ++j) { const unsigned c = xb_ld(&bar[XB_XCNT(j)]); sum += c; cnt += (c > 0u) ? 1u : 0u; mine = (j == x) ? c : mine; }
        if (sum == G) break;
        __builtin_amdgcn_s_sleep(1);
        if ((++sp & 255u) == 0u) { if (xb_ld(&bar[XB_TMO])) break; if (sp > XB_SPIN_CAP) { atomicAdd(&bar[XB_TMO], 1u); break; } }
    }
    nloc = mine > 0u ? mine : 1u; nx = cnt > 0u ? cnt : 1u;
}

__device__ __forceinline__ void xcd_barrier(const XcdBarrier& b) {
    asm volatile("s_waitcnt vmcnt(0)" ::: "memory");
    __syncthreads();
    if (threadIdx.x == 0) {
        unsigned* bar = b.bar;
        __builtin_amdgcn_s_waitcnt(0);
        unsigned nloc = b.st[0], nx = b.st[1];
        if (nloc == 0u) { xcd_barrier_complete(bar, b.x, nloc, nx); b.st[0] = nloc; b.st[1] = nx; }
        const unsigned old = xb_add(&bar[XB_XSUB(b.x)], 1u);
        const unsigned gen = old / nloc;
        if (old + 1u == (gen + 1u) * nloc) {
            __builtin_amdgcn_fence(__ATOMIC_RELEASE, "agent");
            asm volatile("s_waitcnt vmcnt(0)" ::: "memory");
            const unsigned og = xb_add(&bar[XB_TOP], 1u);
            const unsigned tg = og / nx;
            if (og + 1u == (tg + 1u) * nx) xb_add(&bar[XB_TOPGEN], 1u);
            else XB_SPIN(xb_ld(&bar[XB_TOPGEN]) == tg, bar);
            __builtin_amdgcn_fence(__ATOMIC_ACQUIRE, "agent");
            xb_add(&bar[XB_XGEN(b.x)], 1u);
            asm volatile("s_waitcnt vmcnt(0)" ::: "memory");
        } else {
            XB_SPIN(xb_ld(&bar[XB_XGEN(b.x)]) == gen, bar);
            __builtin_amdgcn_fence(__ATOMIC_ACQUIRE, "agent");
            asm volatile("s_waitcnt vmcnt(0)" ::: "memory");
        }
    }
    __syncthreads();
}

__global__ void __launch_bounds__(512, 2) fwd_mega(Args a) {
    extern __shared__ __attribute__((aligned(16))) unsigned char lds_raw[];
    LAS unsigned char* lds = (LAS unsigned char*)lds_raw;
    cg::grid_group grid = cg::this_grid();
    const int tid = threadIdx.x, lane = tid & 63, wave = __builtin_amdgcn_readfirstlane(tid >> 6), bid = blockIdx.x, G = gridDim.x;
    const int gw = bid * 8 + wave, NGW = G * 8;
    unsigned char* ws = a.ws;
    const int lo = a.ph_lo, hi = a.ph_hi;
    volatile LAS unsigned* bst = (volatile LAS unsigned*)(lds + 131072 + 256);
    if (tid < 2) bst[tid] = 0u;
    __syncthreads();
    const XcdBarrier bar = xcd_barrier_post((unsigned*)(ws + WS_BAR), bst);
#define IN(k) (lo <= (k) && (k) < hi)
#define SEAM(k) do { if (IN(k) && IN((k) + 1)) xcd_barrier(bar); } while (0)
    if (hi < 0) grid.sync();

    if (IN(0)) phase0(a, lds, tid, lane, wave, bid, G);
    SEAM(0);
    if (IN(1)) {
        fold_uw(a, lds, tid, bid, G);
        norm_rows<false>(a, a.xp, a.xs, a.g_attn, 0, 1024, nullptr, (bf16*)(ws + WS_H), lane, gw, NGW);
    }
    SEAM(1);
    if (IN(2)) {
        { pg8::Gemm g{(const bf16*)(ws + WS_H), (const bf16*)(ws + WS_WQK), NTOK, 1024, 1024}; pg8::StaticOrder S; S.init(NTOK, 1024, G, bid);
          EpiQK E{(bf16*)(ws + WS_Q), (bf16*)(ws + WS_K), a.g_q, a.g_k};
          pg8::gemm_phase<EpiQK, pg8::StaticOrder, true, true>(lds, g, S, E); }
        { pg8::Gemm g{(const bf16*)(ws + WS_WUV), (const bf16*)(ws + WS_H), 1024, NTOK_S, 1024}; UOrder<128> S{G, bid, NTOK_S / 256, NTOK_P};
          EpiU<128> E{(bf16*)(ws + WS_UTS)};
          pg8::gemm_phase<EpiU<128>, UOrder<128>, true, true>(lds, g, S, E); }
        { pg8::Gemm g{(const bf16*)(ws + WS_WUV), (const bf16*)(ws + WS_H), 1024, NTOK_P, 1024}; UOrder<64> S{G, bid, NTOK_P / 256, 0};
          EpiU<64> E{(bf16*)(ws + WS_UTP)};
          pg8::gemm_phase<EpiU<64>, UOrder<64>, true, true>(lds, g, S, E); }
        { pg8::Gemm g{(const bf16*)(ws + WS_WUV) + (size_t)1024 * 1024, (const bf16*)(ws + WS_H), 512, NTOK, 1024}; pg8::StaticOrder S; S.init(512, NTOK, G, bid);
          EpiV E{ws};
          pg8::gemm_phase<EpiV, pg8::StaticOrder, true, true>(lds, g, S, E); }
    }
    SEAM(2);
    if (IN(3)) {
        int k256 = 256, k128 = 128; asm volatile("" : "+s"(k256), "+s"(k128));
        int zm = 0; asm volatile("" : "+s"(zm));
        if (bid & 1) attn_phase(a, lds, tid, lane, wave, bid, G, 0, AT_SPLIT);
        { pg8::Gemm g{(const bf16*)(ws + WS_DAS), (const bf16*)(ws + WS_UTS), 256, 8 * 512 * 64, k256}; RowOrder S{G, bid, 8 * 512 * 64 / 256, 0, zm};
          EpiA<128> E{(bf16*)(ws + WS_YS)};
          pg8::gemm_phase<EpiA<128>, RowOrder, true, true>(lds, g, S, E); }
        { pg8::Gemm g{(const bf16*)(ws + WS_DAP), (const bf16*)(ws + WS_UTP), 256, 4 * 512 * 64, k128}; RowOrder S{G, bid, 4 * 512 * 64 / 256, 0, zm};
          EpiA<64> E{(bf16*)(ws + WS_YP)};
          pg8::gemm_phase<EpiA<64>, RowOrder, true, true>(lds, g, S, E); }
        if (!(bid & 1)) attn_phase(a, lds, tid, lane, wave, bid, G, 0, AT_SPLIT);
    }
    SEAM(3);
    if (IN(4)) {   int k128 = 128; asm volatile("" : "+s"(k128));
        if (bid & 1) attn_phase(a, lds, tid, lane, wave, bid, G, AT_SPLIT, 1 << 20);
        { pg8::Gemm g{(const bf16*)(ws + WS_DBS), (const bf16*)(ws + WS_YS), 128 * 256, 8 * 128 * 512, k128}; RowOrder S{G, bid, 8 * 128 * 512 / 256, 1, 127};
          EpiB<128> E{(bf16*)(ws + WS_CAT), (float*)(ws + WS_SSQF), NTOK_P};
          pg8::gemm_phase<EpiB<128>, RowOrder, true, true>(lds, g, S, E); }
        { pg8::Gemm g{(const bf16*)(ws + WS_DBP), (const bf16*)(ws + WS_YP), 64 * 256, 4 * 64 * 512, k128}; RowOrder S{G, bid, 4 * 64 * 512 / 256, 1, 63};
          EpiB<64> E{(bf16*)(ws + WS_CAT), (float*)(ws + WS_SSQF), 0};
          pg8::gemm_phase<EpiB<64>, RowOrder, true, true>(lds, g, S, E); }
        if (!(bid & 1)) attn_phase(a, lds, tid, lane, wave, bid, G, AT_SPLIT, 1 << 20);
    }
    SEAM(4);
    if (IN(5)) {
        pg8::Gemm g{(const bf16*)(ws + WS_CAT), (const bf16*)(ws + WS_WO), NTOK, 1024, 1024}; pg8::StaticOrder S; S.init(NTOK, 1024, G, bid);
        LAS float* rs = (LAS float*)(lds + 131072 + 1024);
        { const float* sf = (const float*)(ws + WS_SSQF); const float* sa = (const float*)(ws + WS_SSQA); Unit uu;
          for (int i = 0; i < 7 && S.next(i, uu); ++i) if (tid < 256) { const int tok = uu.pm * 256 + tid;
              const float qa = sa[tok] * (1.0f / 512.0f) + EPS, qf = sf[tok] * (1.0f / 512.0f) + EPS; rs[i * 512 + 2 * tid] = sqrtf(qa / qf); rs[i * 512 + 2 * tid + 1] = rsqrtf(qa); }
          __syncthreads(); }
        EpiWo E{a.xp, a.xs, (bf16*)(ws + WS_XB), (const float*)(ws + WS_MOD), (float*)(ws + WS_SSQ), rs};
        pg8::gemm_phase<EpiWo, pg8::StaticOrder, true, true>(lds, g, S, E);
    }
    SEAM(5);
    if (IN(6)) norm_rows<true>(a, (const float*)(ws + WS_XB), nullptr, a.g_ffn, 3072, 4096, (const float*)(ws + WS_SSQ), (bf16*)(ws + WS_H), lane, gw, NGW);
    SEAM(6);
    if (IN(7)) {
        pg8::Gemm g{(const bf16*)(ws + WS_H), (const bf16*)(ws + WS_WGU), NTOK, 2 * DFF, 1024}; pg8::StaticOrder S; S.init(NTOK, 2 * DFF, G, bid);
        EpiUp E{(bf16*)(ws + WS_HID)};
        pg8::gemm_phase<EpiUp, pg8::StaticOrder, true, true>(lds, g, S, E);
    }
    SEAM(7);
    if (IN(8)) {
        pg8::Gemm g{(const bf16*)(ws + WS_HID), (const bf16*)(ws + WS_WD), NTOK, 1024, DFF}; pg8::StaticOrder S; S.init(NTOK, 1024, G, bid);
        EpiDown E{a.out, (const bf16*)(ws + WS_XB), (const float*)(ws + WS_MOD)};
        pg8::gemm_phase<EpiDown, pg8::StaticOrder, true, true>(lds, g, S, E);
    }
#undef IN
#undef SEAM
}

#ifndef MK_N_LAUNCHES
#define MK_N_LAUNCHES 1
#endif
extern "C" void kernel_launch(void* const* d_in, const int* in_sizes, int n_in, void* d_out, int out_size, void* d_ws, size_t ws_size, hipStream_t stream) {
    static int grid = 0;
    if (grid == 0) {
        if (n_in != 19 || out_size != NTOK * D || ws_size < WS_END) { fprintf(stderr, "kernel_launch: unexpected shapes (n_in %d, out %d, ws %zu)\n", n_in, out_size, ws_size); grid = -1; return; }
        int dev = 0, cus = 0, per_cu = 0;
        hipGetDevice(&dev); hipDeviceGetAttribute(&cus, hipDeviceAttributeMultiprocessorCount, dev);
        if (hipFuncSetAttribute((const void*)fwd_mega, hipFuncAttributeMaxDynamicSharedMemorySize, LDS_BYTES) != hipSuccess) { fprintf(stderr, "kernel_launch: hipFuncSetAttribute failed\n"); grid = -1; return; }
        hipOccupancyMaxActiveBlocksPerMultiprocessor(&per_cu, (const void*)fwd_mega, 512, LDS_BYTES);
        (void)hipGetLastError();
        if (per_cu < 1) { fprintf(stderr, "kernel_launch: occupancy query says %d blocks per CU\n", per_cu); per_cu = 1; }
        grid = cus;
    }
    if (grid < 0) return;
    hipMemsetAsync((char*)d_ws + WS_SSQ, 0, 1 * MiB, stream);
    Args a{};
    a.xp = (const float*)d_in[0]; a.xs = (const float*)d_in[1]; a.cp = (const float*)d_in[2]; a.cs = (const float*)d_in[3]; a.w_ada = (const float*)d_in[4]; a.b_ada = (const float*)d_in[5];
    a.g_attn = (const float*)d_in[6]; a.w_in = (const float*)d_in[7]; a.g_q = (const float*)d_in[8]; a.g_k = (const float*)d_in[9]; a.w_fmix = (const float*)d_in[10]; a.rpb = (const float*)d_in[11];
    a.g_fout = (const float*)d_in[12]; a.g_aout = (const float*)d_in[13]; a.w_o = (const float*)d_in[14]; a.g_ffn = (const float*)d_in[15]; a.w_gate = (const float*)d_in[16]; a.w_up = (const float*)d_in[17];
    a.w_down = (const float*)d_in[18]; a.out = (float*)d_out; a.ws = (unsigned char*)d_ws;
#if MK_N_LAUNCHES == 1
    a.ph_lo = 0; a.ph_hi = 9;
    void* args[] = {&a};
    hipError_t e = hipLaunchCooperativeKernel((const void*)fwd_mega, dim3(grid), dim3(512), args, LDS_BYTES, stream);
    if (e != hipSuccess) fprintf(stderr, "kernel_launch: cooperative launch failed: %s (grid %d)\n", hipGetErrorString(e), grid);
#else
    for (int p = 0; p < 9; ++p) { a.ph_lo = p; a.ph_hi = p + 1; hipLaunchKernelGGL(fwd_mega, dim3(grid), dim3(512), LDS_BYTES, stream, a); }
#endif
}
```

```cpp
#include <hip/hip_runtime.h>
#include <hip/hip_cooperative_groups.h>
#include <cstdio>
#include <cstdint>
namespace cg = cooperative_groups;

namespace pg8 {
#define PG8_LAS __attribute__((address_space(3)))
typedef unsigned short bf16_t;
typedef short bf16x8 __attribute__((ext_vector_type(8)));
typedef float f32x4 __attribute__((ext_vector_type(4)));
typedef unsigned u32x4 __attribute__((ext_vector_type(4)));
constexpr int BM = 256, BK = 64, HALF = 128, HTB = HALF * BK * 2  , STAGE_BYTES = 8 * HTB, NXCD = 8, WGM = 4;

__host__ __device__ __forceinline__ int lds_byte(int r, int c) { const int st = (r >> 4) * 2 + (c >> 5), rr = r & 15, cc = c & 31, ob = rr * 64 + cc * 2; return st * 1024 + (ob ^ (((ob >> 9) & 1) << 5)); }
__host__ __device__ __forceinline__ void stage_rc(int b, int& R, int& C) { const int st = b / 1024, sb = b % 1024, swz = sb ^ (((sb >> 9) & 1) << 5); R = (st >> 1) * 16 + swz / 64; C = (st & 1) * 32 + (swz % 64) / 2; }
__host__ __device__ __forceinline__ int perm32(int rho) { const int n = rho >> 4, i = rho & 15; return 8 * (i >> 2) + 4 * n + (i & 3); }

struct Unit { int pm, pn; };
struct Gemm { const bf16_t* A; const bf16_t* Bt; int M, N, K; };

struct StaticOrder {
    static constexpr bool CUSTOMB = false;
    int nM, nN, nwg, G, c;
    __host__ __device__ void init(int M, int N, int G_, int c_) { nM = M / BM; nN = N / BM; nwg = nM * nN; G = G_; c = c_; }
    __host__ __device__ bool next(int i, Unit& u) const {
        const long L = (long)i * G + c; if (L >= nwg) return false;
        int wgid = (int)L; { const int q = nwg / NXCD, r = nwg % NXCD, xcd = wgid % NXCD, off = wgid / NXCD; wgid = (xcd < r ? xcd * (q + 1) : r * (q + 1) + (xcd - r) * q) + off; }
        const int nig = WGM * nN, gid = wgid / nig, fm = gid * WGM, gsz = (nM - fm) < WGM ? (nM - fm) : WGM;
        u.pm = fm + ((wgid % nig) % gsz); u.pn = (wgid % nig) / gsz; return true;
    }
    __device__ __forceinline__ void a_ready(const Unit&) const {}
    __device__ __forceinline__ void done(const Unit&) const {}
};

__device__ __forceinline__ unsigned cvt_pk_bf16(float lo, float hi) { unsigned r; asm volatile("v_cvt_pk_bf16_f32 %0, %1, %2" : "=v"(r) : "v"(lo), "v"(hi)); return r; }
template <class Epi, class Sched, bool ALIGN_EPI = false, bool SP2 = false>
__device__ __forceinline__ void gemm_phase(PG8_LAS unsigned char* lds, const Gemm g, const Sched& S, const Epi& E) {
    const int tid = threadIdx.x, wid = __builtin_amdgcn_readfirstlane(tid >> 6), lane = tid & 63, wr = wid >> 2, wc = wid & 3, fr = lane & 15, fq = lane >> 4;
    const int K = g.K, nt = K / BK;
    unsigned voffA[2], voffB[2];
#pragma unroll
    for (int i = 0; i < 2; ++i) { int R, C; stage_rc(tid * 16 + i * 8192, R, C); const int Rb = Epi::PERM ? ((R & ~31) + perm32(R & 31)) : R;
        voffA[i] = (unsigned)(R * K + C) * 2u; if constexpr (Sched::CUSTOMB) voffB[i] = S.b_voff(Rb, C, K); else voffB[i] = (unsigned)(Rb * K + C) * 2u; }
    const size_t kstep = (size_t)(BK * 2);
    const size_t hstep = (size_t)HALF * K * 2;
    const size_t tstep = 2 * hstep;
    size_t hstepB = hstep; if constexpr (Sched::CUSTOMB) hstepB = S.b_hstep(K);
    const unsigned ldsw = (unsigned)wid * 1024u;
    const int aoff = lds_byte(wr * 64 + fr, fq * 8), boff = lds_byte(wc * 32 + fr, fq * 8);
#define PG8_SA(b, h) (((b) * 2 + (h)) * HTB)
#define PG8_SB(b, h) ((4 + (b) * 2 + (h)) * HTB)
#define PG8_STAGE(bufoff, gbase, voff) do { _Pragma("unroll") for (int _i = 0; _i < 2; ++_i) \
        __builtin_amdgcn_global_load_lds((const unsigned*)((const char*)(gbase) + (voff)[_i]), (PG8_LAS unsigned*)(lds + (bufoff) + ldsw + _i * 8192), 16, 0, 0); } while (0)
#define PG8_LDA(dst, b, h) do { _Pragma("unroll") for (int m = 0; m < 4; ++m) _Pragma("unroll") for (int k = 0; k < 2; ++k) dst[m][k] = *(const PG8_LAS bf16x8*)(lds + PG8_SA(b, h) + aoff + m * 2048 + k * 1024); } while (0)
#define PG8_LDB(dst, b, h) do { _Pragma("unroll") for (int n = 0; n < 2; ++n) _Pragma("unroll") for (int k = 0; k < 2; ++k) dst[n][k] = *(const PG8_LAS bf16x8*)(lds + PG8_SB(b, h) + boff + n * 2048 + k * 1024); } while (0)
#define PG8_MMA(ai, bj, At, Bt) do { __builtin_amdgcn_s_setprio(1); _Pragma("unroll") for (int m = 0; m < 4; ++m) _Pragma("unroll") for (int n = 0; n < 2; ++n) _Pragma("unroll") for (int k = 0; k < 2; ++k) \
        acc[ai][bj][m][n] = __builtin_amdgcn_mfma_f32_16x16x32_bf16(Bt[n][k], At[m][k], acc[ai][bj][m][n], 0, 0, 0); __builtin_amdgcn_s_setprio(0); } while (0)
#define PG8_WAIT_V(n) asm volatile("s_waitcnt vmcnt(" #n ")" ::: "memory")
#define PG8_WAIT_L(n) asm volatile("s_waitcnt lgkmcnt(" #n ")" ::: "memory")
#define PG8_BAR __builtin_amdgcn_s_barrier()
#define PG8_SCHED __builtin_amdgcn_sched_barrier(0)
    Unit cur, nxt; int ui = 0;
    if (!S.next(0, cur)) return;
    f32x4 acc[2][2][4][2];
#pragma unroll
    for (int a = 0; a < 2; ++a)
#pragma unroll
        for (int b = 0; b < 2; ++b)
#pragma unroll
            for (int m = 0; m < 4; ++m)
#pragma unroll
                for (int n = 0; n < 2; ++n) acc[a][b][m][n] = (f32x4){0.f, 0.f, 0.f, 0.f};
    bf16x8 At[4][2], B0[2][2], B1[2][2];
    const char* cA = (const char*)g.A + (size_t)cur.pm * tstep; const char* cB; if constexpr (Sched::CUSTOMB) cB = (const char*)g.Bt + S.b_off(cur.pn, K); else cB = (const char*)g.Bt + (size_t)cur.pn * tstep;
    S.a_ready(cur);
    if constexpr (SP2) {
        PG8_STAGE(PG8_SB(0, 0), cB, voffB); PG8_STAGE(PG8_SB(0, 1), cB + hstepB, voffB); PG8_STAGE(PG8_SA(0, 0), cA, voffA); PG8_STAGE(PG8_SA(0, 1), cA + hstep, voffA);
        if (wr == 1) PG8_BAR;
        PG8_WAIT_V(2); PG8_BAR;
        PG8_STAGE(PG8_SB(1, 0), cB + kstep, voffB); PG8_STAGE(PG8_SA(1, 0), cA + kstep, voffA); PG8_STAGE(PG8_SB(1, 1), cB + hstepB + kstep, voffB);
        PG8_WAIT_V(6); PG8_BAR;
    } else {
        PG8_STAGE(PG8_SB(0, 0), cB, voffB); PG8_STAGE(PG8_SA(0, 0), cA, voffA); PG8_STAGE(PG8_SB(0, 1), cB + hstepB, voffB); PG8_STAGE(PG8_SA(0, 1), cA + hstep, voffA);
        if (wr == 1) PG8_BAR;
        PG8_WAIT_V(4); PG8_BAR;
        PG8_STAGE(PG8_SB(1, 0), cB + kstep, voffB); PG8_STAGE(PG8_SA(1, 0), cA + kstep, voffA); PG8_STAGE(PG8_SB(1, 1), cB + hstepB + kstep, voffB);
        PG8_WAIT_V(6); PG8_BAR;
    }
    for (;;) {
        const bool has_next = S.next(ui + 1, nxt);
        const char* nA = has_next ? (const char*)g.A + (size_t)nxt.pm * tstep : cA; const char* nB; if constexpr (Sched::CUSTOMB) nB = has_next ? (const char*)g.Bt + S.b_off(nxt.pn, K) : cB; else nB = has_next ? (const char*)g.Bt + (size_t)nxt.pn * tstep : cB;
        for (int seg = 0; seg < (Epi::MIDK ? 2 : 1); ++seg) {
        int t_lo = 0, t_hi = nt;
        if constexpr (Epi::MIDK) { if (seg == 0) t_hi = Epi::MIDT; else { t_lo = Epi::MIDT; E.mid(acc, ui, wr, wc, fr, fq); } }
        for (int t = t_lo; t < t_hi; t += 2) {
            const bool last = (t == nt - 2);
            const char* a1 = cA + (size_t)(t + 1) * kstep;
            const char* a2 = last ? nA : cA + (size_t)(t + 2) * kstep; const char* b2 = last ? nB : cB + (size_t)(t + 2) * kstep;
            const char* a3 = a2 + kstep; const char* b3 = b2 + kstep;
            if (last && has_next) S.a_ready(nxt);
            if constexpr (SP2) {
            PG8_LDB(B0, 0, 0); PG8_LDB(B1, 0, 1); PG8_SCHED; PG8_LDA(At, 0, 0); PG8_STAGE(PG8_SA(1, 1), a1 + hstep, voffA);
            PG8_WAIT_V(8); PG8_WAIT_L(0); PG8_BAR; PG8_MMA(0, 0, At, B0); PG8_MMA(0, 1, At, B1); PG8_BAR; PG8_SCHED;
            PG8_LDA(At, 0, 1); PG8_STAGE(PG8_SB(0, 0), b2, voffB); PG8_STAGE(PG8_SB(0, 1), b2 + hstepB, voffB); PG8_STAGE(PG8_SA(0, 0), a2, voffA);
            PG8_WAIT_V(8); PG8_WAIT_L(0); PG8_BAR; PG8_MMA(1, 0, At, B0); PG8_MMA(1, 1, At, B1); PG8_BAR; PG8_SCHED;
            PG8_LDB(B0, 1, 0); PG8_LDB(B1, 1, 1); PG8_SCHED; PG8_LDA(At, 1, 0); PG8_STAGE(PG8_SA(0, 1), a2 + hstep, voffA);
            PG8_WAIT_V(8); PG8_WAIT_L(0); PG8_BAR; PG8_MMA(0, 0, At, B0); PG8_MMA(0, 1, At, B1); PG8_BAR; PG8_SCHED;
            PG8_LDA(At, 1, 1); PG8_STAGE(PG8_SB(1, 0), b3, voffB); PG8_STAGE(PG8_SB(1, 1), b3 + hstepB, voffB); PG8_STAGE(PG8_SA(1, 0), a3, voffA);
            PG8_WAIT_V(8); PG8_WAIT_L(0); PG8_BAR; PG8_MMA(1, 0, At, B0); PG8_MMA(1, 1, At, B1); PG8_BAR; PG8_SCHED;
            } else {
            PG8_LDB(B0, 0, 0); PG8_SCHED; PG8_LDA(At, 0, 0); PG8_STAGE(PG8_SA(1, 1), a1 + hstep, voffA);
            PG8_WAIT_L(8); PG8_BAR; PG8_WAIT_L(0); PG8_MMA(0, 0, At, B0); PG8_BAR; PG8_SCHED;
            PG8_LDB(B1, 0, 1); PG8_STAGE(PG8_SB(0, 0), b2, voffB);
            PG8_BAR; PG8_WAIT_L(0); PG8_MMA(0, 1, At, B1); PG8_BAR;
            PG8_LDA(At, 0, 1); PG8_STAGE(PG8_SA(0, 0), a2, voffA);
            PG8_BAR; PG8_WAIT_L(0); PG8_MMA(1, 0, At, B0); PG8_BAR; PG8_SCHED;
            PG8_STAGE(PG8_SB(0, 1), b2 + hstepB, voffB);
            PG8_WAIT_V(6); PG8_BAR; PG8_MMA(1, 1, At, B1); PG8_BAR;
            PG8_LDB(B0, 1, 0); PG8_SCHED; PG8_LDA(At, 1, 0); PG8_STAGE(PG8_SA(0, 1), a2 + hstep, voffA);
            PG8_WAIT_L(8); PG8_BAR; PG8_WAIT_L(0); PG8_MMA(0, 0, At, B0); PG8_BAR; PG8_SCHED;
            PG8_LDB(B1, 1, 1); PG8_STAGE(PG8_SB(1, 0), b3, voffB);
            PG8_BAR; PG8_WAIT_L(0); PG8_MMA(0, 1, At, B1); PG8_BAR;
            PG8_LDA(At, 1, 1); PG8_STAGE(PG8_SA(1, 0), a3, voffA);
            PG8_BAR; PG8_WAIT_L(0); PG8_MMA(1, 0, At, B0); PG8_BAR; PG8_SCHED;
            PG8_STAGE(PG8_SB(1, 1), b3 + hstepB, voffB);
            PG8_WAIT_V(6); PG8_BAR; PG8_MMA(1, 1, At, B1); PG8_BAR;
            }
        }
        }
        if constexpr (ALIGN_EPI) { if (wr == 0) PG8_BAR; }
        if constexpr (!Epi::AFTER_DRAIN) { if constexpr (Epi::MIDK) E.fin(acc, cur, ui, wr, wc, fr, fq); else E(acc, cur, wr, wc, fr, fq); S.done(cur); }
        if (!has_next) break;
#pragma unroll
        for (int a = 0; a < 2; ++a)
#pragma unroll
            for (int b = 0; b < 2; ++b)
#pragma unroll
                for (int m = 0; m < 4; ++m)
#pragma unroll
                    for (int n = 0; n < 2; ++n) acc[a][b][m][n] = (f32x4){0.f, 0.f, 0.f, 0.f};
        cur = nxt; cA = nA; cB = nB; ++ui;
        if constexpr (ALIGN_EPI) { if (wr == 1) PG8_BAR; }
    }
    PG8_WAIT_V(0);
    if constexpr (!ALIGN_EPI) { if (wr == 0) PG8_BAR; }
    PG8_BAR;
    if constexpr (Epi::AFTER_DRAIN) { E.fused(acc, cur, wr, wc, fr, fq, lds, wid, lane); S.done(cur); }
#undef PG8_SA
#undef PG8_SB
#undef PG8_STAGE
#undef PG8_LDA
#undef PG8_LDB
#undef PG8_MMA
#undef PG8_WAIT_V
#undef PG8_WAIT_L
#undef PG8_BAR
#undef PG8_SCHED
}
}

#define GAS __attribute__((address_space(1)))
#define LAS __attribute__((address_space(3)))
typedef unsigned short bf16;
typedef unsigned v4u __attribute__((ext_vector_type(4)));
typedef unsigned v2u __attribute__((ext_vector_type(2)));
typedef float f32x4 __attribute__((ext_vector_type(4)));
typedef short bf16x8 __attribute__((ext_vector_type(8)));
using pg8::Unit;
using pg8::cvt_pk_bf16;

constexpr int D = 1024, TP = 4096, TS = 8192, NTOK_P = 4 * TP, NTOK_S = 8 * TS, NTOK = NTOK_P + NTOK_S;
constexpr int DFF = 2816, NMOD = 6144;
constexpr float EPS = 1e-6f;
constexpr size_t MiB = 1u << 20;
constexpr size_t WS_SSQ = 0;
constexpr size_t WS_SSQA = 320 * 1024;
constexpr size_t WS_SSQF = 640 * 1024;
constexpr size_t WS_BAR = 960 * 1024;
constexpr size_t WS_MOD = 1 * MiB;
constexpr size_t WS_CS = 1 * MiB + 512 * 1024;
constexpr size_t WS_ECH = 2 * MiB;
constexpr size_t WS_DAS = 2 * MiB + 256 * 1024;
constexpr size_t WS_DAP = 2 * MiB + 512 * 1024;
constexpr size_t WS_WQK = 4 * MiB;
constexpr size_t WS_WUV = 6 * MiB;
constexpr size_t WS_WO = 10 * MiB;
constexpr size_t WS_WGU = 12 * MiB;
constexpr size_t WS_WD = 24 * MiB;
constexpr size_t WS_H = 32 * MiB;
constexpr size_t WS_Q = 192 * MiB;
constexpr size_t WS_K = 272 * MiB;
constexpr size_t WS_VTP = 352 * MiB;
constexpr size_t WS_VTS = 368 * MiB;
constexpr size_t WS_UTP = 432 * MiB;
constexpr size_t WS_UTS = 464 * MiB;
constexpr size_t WS_YP = 592 * MiB;
constexpr size_t WS_YS = 624 * MiB;
constexpr size_t WS_HID = 192 * MiB;
constexpr size_t WS_DBS = 752 * MiB;
constexpr size_t WS_DBP = 760 * MiB;
constexpr size_t WS_XB = 640 * MiB;
constexpr size_t WS_CAT = 832 * MiB;
constexpr size_t WS_END = 992 * MiB;
constexpr int LDS_BYTES = 151552;
#ifndef AT_SPLIT
#define AT_SPLIT 3
#endif

struct Args {
    const float *xp, *xs, *cp, *cs, *w_ada, *b_ada, *g_attn, *w_in, *g_q, *g_k, *w_fmix, *rpb, *g_fout, *g_aout, *w_o, *g_ffn, *w_gate, *w_up, *w_down;
    float* out; unsigned char* ws; int ph_lo, ph_hi;
};

__device__ __forceinline__ float wave_sum(float v) {
#pragma unroll
    for (int o = 1; o < 64; o <<= 1) v += __shfl_xor(v, o);
    return v;
}
__device__ __forceinline__ int batch_of(int tok) { return tok < NTOK_P ? (tok >> 12) : 4 + ((tok - NTOK_P) >> 13); }
__device__ __forceinline__ float bf_lo(unsigned w) { return __uint_as_float(w << 16); }
__device__ __forceinline__ float bf_hi(unsigned w) { return __uint_as_float(w & 0xffff0000u); }

struct RowOrder {
    static constexpr bool CUSTOMB = false;
    int G, c, nN, pshift, pmask;
    __device__ bool next(int i, Unit& u) const { const long L = (long)i * G + c; if (L >= nN) return false; u.pm = ((int)L >> pshift) & pmask; u.pn = (int)L; return true; }
    __device__ __forceinline__ void a_ready(const Unit&) const {}
    __device__ __forceinline__ void done(const Unit&) const {}
};
template <int T1> struct UOrder {
    static constexpr bool CUSTOMB = true;
    int G, c, nN, tokbase;
    __device__ bool next(int i, Unit& u) const { const long L = (long)i * G + c; if (L >= 4L * nN) return false; u.pm = (int)(L & 3); u.pn = (int)(L >> 2); return true; }
    __device__ __forceinline__ void a_ready(const Unit&) const {}
    __device__ __forceinline__ void done(const Unit&) const {}
    __device__ __forceinline__ unsigned b_voff(int Rb, int C, int K) const { const int tokoff = (T1 == 128) ? Rb * 64 : ((Rb & 63) * 64 + (Rb >> 6)); return (unsigned)(tokoff * K + C) * 2u; }
    __device__ __forceinline__ size_t b_hstep(int K) const { return (size_t)((T1 == 128) ? 1 : 2) * K * 2; }
    __device__ __forceinline__ size_t b_off(int pn, int K) const {
        const int n0 = pn * 256; int tok;
        if (T1 == 128) tok = tokbase + (n0 >> 13) * 8192 + ((n0 & 8191) >> 7); else tok = tokbase + (n0 >> 12) * 4096 + ((n0 & 4095) >> 6);
        return (size_t)tok * K * 2;
    }
};

struct EpiQK {
    static constexpr bool MIDK = false; static constexpr bool PERM = true, AFTER_DRAIN = false;
    bf16* Q; bf16* K; const float* gq; const float* gk;
    __device__ __forceinline__ void operator()(const f32x4 (&acc)[2][2][4][2], const Unit& u, int wr, int wc, int fr, int fq) const {
        const bool isq = u.pn < 2; bf16* base = isq ? Q : K; const float* g = isq ? gq : gk; const float sc = isq ? 0.125f * 1.4426950408889634f : 1.0f;
        const int head = 4 * (u.pn & 1) + wc;
        f32x4 gv[2][2];
#pragma unroll
        for (int bj = 0; bj < 2; ++bj)
#pragma unroll
            for (int n = 0; n < 2; ++n) gv[bj][n] = *(const f32x4*)(g + 32 * bj + 8 * fq + 4 * n) * sc;
#pragma unroll
        for (int ai = 0; ai < 2; ++ai)
#pragma unroll
            for (int m = 0; m < 4; ++m) {
                float ss = 0.f;
#pragma unroll
                for (int bj = 0; bj < 2; ++bj)
#pragma unroll
                    for (int n = 0; n < 2; ++n) { const f32x4 v = acc[ai][bj][m][n]; ss += (v[0] * v[0] + v[1] * v[1]) + (v[2] * v[2] + v[3] * v[3]); }
                ss += __shfl_xor(ss, 16); ss += __shfl_xor(ss, 32);
                const float rstd = rsqrtf(ss * (1.0f / 64.0f) + EPS);
                const int row = u.pm * 256 + ai * 128 + wr * 64 + m * 16 + fr;
                bf16* p = base + (size_t)row * 512 + head * 64 + 8 * fq;
#pragma unroll
                for (int bj = 0; bj < 2; ++bj) {
                    const f32x4 v0 = acc[ai][bj][m][0] * gv[bj][0] * rstd, v1 = acc[ai][bj][m][1] * gv[bj][1] * rstd;
                    v4u w; w.x = cvt_pk_bf16(v0[0], v0[1]); w.y = cvt_pk_bf16(v0[2], v0[3]); w.z = cvt_pk_bf16(v1[0], v1[1]); w.w = cvt_pk_bf16(v1[2], v1[3]);
                    *(v4u*)(p + 32 * bj) = w;
                }
            }
    }
};
template <int T1> struct EpiU {
    static constexpr bool MIDK = false; static constexpr bool PERM = true, AFTER_DRAIN = false;
    bf16* UT;
    __device__ __forceinline__ void operator()(const f32x4 (&acc)[2][2][4][2], const Unit& u, int wr, int wc, int fr, int fq) const {
#pragma unroll
        for (int ai = 0; ai < 2; ++ai)
#pragma unroll
            for (int m = 0; m < 4; ++m) {
                const int cp = u.pm * 256 + ai * 128 + wr * 64 + m * 16 + fr, cs = cp >> 9, ch = cp & 511;
#pragma unroll
                for (int bj = 0; bj < 2; ++bj) {
                    const int nb = u.pn * 256 + bj * 128 + wc * 32 + 8 * fq;
                    size_t addr;
                    if (T1 == 128) { const int sq = nb >> 13, nl = nb & 8191, t2 = nl >> 7, t1 = nl & 127; addr = ((size_t)((sq * 512 + ch) * 64 + t2)) * 256 + cs * 128 + t1; }
                    else { const int sq = nb >> 12, nl = nb & 4095, t2 = nl >> 6, t1 = nl & 63; addr = ((size_t)((sq * 512 + ch) * 64 + t2)) * 128 + cs * 64 + t1; }
                    const f32x4 v0 = acc[ai][bj][m][0], v1 = acc[ai][bj][m][1];
                    v4u w; w.x = cvt_pk_bf16(v0[0], v0[1]); w.y = cvt_pk_bf16(v0[2], v0[3]); w.z = cvt_pk_bf16(v1[0], v1[1]); w.w = cvt_pk_bf16(v1[2], v1[3]);
                    *(v4u*)(UT + addr) = w;
                }
            }
    }
};
struct EpiV {
    static constexpr bool MIDK = false; static constexpr bool PERM = true, AFTER_DRAIN = false;
    unsigned char* ws;
    __device__ __forceinline__ void operator()(const f32x4 (&acc)[2][2][4][2], const Unit& u, int wr, int wc, int fr, int fq) const {
        const int tokt = u.pn * 256; const bool isP = tokt < NTOK_P;
        int b, t0, T;
        if (isP) { b = tokt >> 12; t0 = tokt & 4095; T = TP; } else { const int tt = tokt - NTOK_P; b = tt >> 13; t0 = tt & 8191; T = TS; }
        bf16* dst = (bf16*)(ws + (isP ? WS_VTP : WS_VTS));
        const int rowbase = b * 512 + u.pm * 256;
#pragma unroll
        for (int ai = 0; ai < 2; ++ai)
#pragma unroll
            for (int m = 0; m < 4; ++m) {
                const int r = rowbase + ai * 128 + wr * 64 + m * 16 + fr;
                bf16* p = dst + (size_t)r * T + t0 + wc * 32 + 8 * fq;
#pragma unroll
                for (int bj = 0; bj < 2; ++bj) {
                    const f32x4 v0 = acc[ai][bj][m][0], v1 = acc[ai][bj][m][1];
                    v4u w; w.x = cvt_pk_bf16(v0[0], v0[1]); w.y = cvt_pk_bf16(v0[2], v0[3]); w.z = cvt_pk_bf16(v1[0], v1[1]); w.w = cvt_pk_bf16(v1[2], v1[3]);
                    *(v4u*)(p + 128 * bj) = w;
                }
            }
    }
};
template <int T1> struct EpiA {
    static constexpr bool MIDK = false; static constexpr bool PERM = true, AFTER_DRAIN = false;
    bf16* Y;
    __device__ __forceinline__ void operator()(const f32x4 (&acc)[2][2][4][2], const Unit& u, int wr, int wc, int fr, int fq) const {
        if (T1 == 64 && wr != 0) return;
#pragma unroll
        for (int m = 0; m < 4; ++m) {
            const int k1 = (T1 == 128 ? 64 * wr : 0) + 16 * m + fr;
#pragma unroll
            for (int bj = 0; bj < 2; ++bj) {
                const int nb = u.pn * 256 + bj * 128 + wc * 32 + 8 * fq, sq = nb >> 15, ch = (nb >> 6) & 511, t2b = nb & 63;
                bf16* p = Y + ((size_t)((sq * T1 + k1) * 512 + ch)) * 128 + t2b;
#pragma unroll
                for (int ri = 0; ri < 2; ++ri) {
                    const f32x4 v0 = acc[ri][bj][m][0], v1 = acc[ri][bj][m][1];
                    v4u w; w.x = cvt_pk_bf16(v0[0], v0[1]); w.y = cvt_pk_bf16(v0[2], v0[3]); w.z = cvt_pk_bf16(v1[0], v1[1]); w.w = cvt_pk_bf16(v1[2], v1[3]);
                    *(v4u*)(p + 64 * ri) = w;
                }
            }
        }
    }
};
template <int T1> struct EpiB {
    static constexpr bool MIDK = false; static constexpr bool PERM = true, AFTER_DRAIN = false;
    bf16* CAT; float* ssqf; int tokbase;
    __device__ __forceinline__ void operator()(const f32x4 (&acc)[2][2][4][2], const Unit& u, int wr, int wc, int fr, int fq) const {
        if (wr != 0) return;
        const int sk1 = u.pn >> 1, sq = sk1 / T1, k1 = sk1 % T1;
#pragma unroll
        for (int m = 0; m < 4; ++m) {
            const int k2 = 16 * m + fr, tok = tokbase + sq * (64 * T1) + k1 + T1 * k2;
            float ss = 0.f;
#pragma unroll
            for (int bj = 0; bj < 2; ++bj) {
                const int ch = (u.pn & 1) * 256 + bj * 128 + wc * 32 + 8 * fq;
                const f32x4 v0 = acc[0][bj][m][0], v1 = acc[0][bj][m][1];
                ss += (v0[0] * v0[0] + v0[1] * v0[1]) + (v0[2] * v0[2] + v0[3] * v0[3]) + (v1[0] * v1[0] + v1[1] * v1[1]) + (v1[2] * v1[2] + v1[3] * v1[3]);
                v4u w; w.x = cvt_pk_bf16(v0[0], v0[1]); w.y = cvt_pk_bf16(v0[2], v0[3]); w.z = cvt_pk_bf16(v1[0], v1[1]); w.w = cvt_pk_bf16(v1[2], v1[3]);
                *(v4u*)(CAT + (size_t)tok * 1024 + ch) = w;
            }
            ss += __shfl_xor(ss, 16); ss += __shfl_xor(ss, 32);
            if (fq == 0) unsafeAtomicAdd(ssqf + tok, ss);
        }
    }
};
struct EpiWo {
    static constexpr bool MIDK = true; static constexpr int MIDT = 8;
    static constexpr bool PERM = true, AFTER_DRAIN = false;
    const float* xp; const float* xs; bf16* XB; const float* mod; float* ssq; const LAS float* rs;
    __device__ __forceinline__ void mid(f32x4 (&acc)[2][2][4][2], int ui, int wr, int wc, int fr, int fq) const {
#pragma unroll
        for (int ai = 0; ai < 2; ++ai)
#pragma unroll
            for (int m = 0; m < 4; ++m) {
                const float ratio = rs[ui * 512 + 2 * (ai * 128 + wr * 64 + m * 16 + fr)];
#pragma unroll
                for (int bj = 0; bj < 2; ++bj)
#pragma unroll
                    for (int n = 0; n < 2; ++n) acc[ai][bj][m][n] *= ratio;
            }
    }
    __device__ __forceinline__ void fin(const f32x4 (&acc)[2][2][4][2], const Unit& u, int ui, int wr, int wc, int fr, int fq) const {
        const int tokt = u.pm * 256, b = batch_of(tokt);
        const float* xb = tokt < NTOK_P ? xp + (size_t)tokt * D : xs + (size_t)(tokt - NTOK_P) * D;
        const int col0 = u.pn * 256 + wc * 32 + 8 * fq;
        const float* gp = mod + b * NMOD + 2048 + col0;
        bf16* xbo = XB + (size_t)tokt * D;
        f32x4 gt[2][2];
#pragma unroll
        for (int bj = 0; bj < 2; ++bj)
#pragma unroll
            for (int n = 0; n < 2; ++n) gt[bj][n] = *(const f32x4*)(gp + bj * 128 + 4 * n);
#pragma unroll
        for (int ai = 0; ai < 2; ++ai)
#pragma unroll
            for (int mp = 0; mp < 2; ++mp) {
                f32x4 xv[2][2][2];
#pragma unroll
                for (int mm = 0; mm < 2; ++mm)
#pragma unroll
                    for (int bj = 0; bj < 2; ++bj)
#pragma unroll
                        for (int n = 0; n < 2; ++n) xv[mm][bj][n] = *(const f32x4*)(xb + (unsigned)((ai * 128 + wr * 64 + (2 * mp + mm) * 16 + fr) * D + col0 + bj * 128 + 4 * n));
                asm volatile("" ::: "memory");
#pragma unroll
                for (int mm = 0; mm < 2; ++mm) {
                    const int m = 2 * mp + mm, rl = ai * 128 + wr * 64 + m * 16 + fr; float ss = 0.f;
                    const float ra = rs[ui * 512 + 2 * rl + 1];
#pragma unroll
                    for (int bj = 0; bj < 2; ++bj) {
                        const unsigned off = (unsigned)(rl * D + col0 + bj * 128);
                        const f32x4 o0 = xv[mm][bj][0] + gt[bj][0] * (acc[ai][bj][m][0] * ra), o1 = xv[mm][bj][1] + gt[bj][1] * (acc[ai][bj][m][1] * ra);
                        ss += (o0[0] * o0[0] + o0[1] * o0[1]) + (o0[2] * o0[2] + o0[3] * o0[3]) + (o1[0] * o1[0] + o1[1] * o1[1]) + (o1[2] * o1[2] + o1[3] * o1[3]);
                        v4u w; w.x = cvt_pk_bf16(o0[0], o0[1]); w.y = cvt_pk_bf16(o0[2], o0[3]); w.z = cvt_pk_bf16(o1[0], o1[1]); w.w = cvt_pk_bf16(o1[2], o1[3]);
                        *(v4u*)(xbo + off) = w;
                    }
                    ss += __shfl_xor(ss, 16); ss += __shfl_xor(ss, 32);
                    if (fq == 0) unsafeAtomicAdd(ssq + tokt + rl, ss);
                }
            }
    }
};
struct EpiUp {
    static constexpr bool MIDK = false; static constexpr bool PERM = true, AFTER_DRAIN = false;
    bf16* HID;
    __device__ __forceinline__ void operator()(const f32x4 (&acc)[2][2][4][2], const Unit& u, int wr, int wc, int fr, int fq) const {
#pragma unroll
        for (int ai = 0; ai < 2; ++ai)
#pragma unroll
            for (int m = 0; m < 4; ++m) {
                const int row = u.pm * 256 + ai * 128 + wr * 64 + m * 16 + fr;
                bf16* p = HID + (size_t)row * DFF + u.pn * 128 + wc * 32 + 8 * fq;
                float v[8];
#pragma unroll
                for (int n = 0; n < 2; ++n)
#pragma unroll
                    for (int i = 0; i < 4; ++i) { const float g = acc[ai][0][m][n][i], up = acc[ai][1][m][n][i]; v[4 * n + i] = g * __builtin_amdgcn_rcpf(1.0f + __expf(-g)) * up; }
                v4u w; w.x = cvt_pk_bf16(v[0], v[1]); w.y = cvt_pk_bf16(v[2], v[3]); w.z = cvt_pk_bf16(v[4], v[5]); w.w = cvt_pk_bf16(v[6], v[7]);
                *(v4u*)p = w;
            }
    }
};
struct EpiDown {
    static constexpr bool MIDK = false; struct Carry {}; static constexpr bool PERM = false, AFTER_DRAIN = false;
    float* out; const bf16* XB; const float* mod; LAS float* tws;
    __device__ __forceinline__ void operator()(const f32x4 (&acc)[2][2][4][2], const Unit& u, int wr, int wc, int fr, int fq) const {
        const int tokt = u.pm * 256, b = batch_of(tokt);
        const int col0 = u.pn * 256 + wc * 32 + 4 * fq;
        f32x4 gt[2][2];
#pragma unroll
        for (int bj = 0; bj < 2; ++bj)
#pragma unroll
            for (int n = 0; n < 2; ++n) gt[bj][n] = *(const f32x4*)(mod + b * NMOD + 5120 + col0 + bj * 128 + n * 16);
        LAS float* tw = tws + (wr * 4 + wc) * 576;
        const int lane = fq * 16 + fr, rr = lane >> 3, ch = lane & 7;
        const bf16* xbo = XB + (size_t)tokt * D + u.pn * 256 + wc * 32 + 4 * ch; float* oo = out + (size_t)tokt * D + u.pn * 256 + wc * 32 + 4 * ch;
        unsigned off = (unsigned)((wr * 64 + rr) * D);
        v2u xa = *(const v2u*)(xbo + off), xc = *(const v2u*)(xbo + off + 8 * D);
#pragma unroll
        for (int it = 0; it < 16; ++it) {
            const int ai = it >> 3, m = (it >> 1) & 3, bj = it & 1;
            const int delta = (bj == 0) ? 128 : ((m < 3) ? 16 * D - 128 : (128 - 48) * D - 128);
            unsigned nxt = off + (unsigned)delta; asm volatile("" : "+v"(nxt));
            v2u na = xa, nc = xc;
            if (it < 15) { na = *(const v2u*)(xbo + nxt); nc = *(const v2u*)(xbo + nxt + 8 * D); }
#pragma unroll
            for (int n = 0; n < 2; ++n) *(LAS f32x4*)(tw + fr * 36 + 16 * n + 4 * fq) = gt[bj][n] * acc[ai][bj][m][n];
            const f32x4 va = *(const LAS f32x4*)(tw + rr * 36 + 4 * ch), vc = *(const LAS f32x4*)(tw + (rr + 8) * 36 + 4 * ch);
            *(f32x4*)(oo + off) = (f32x4){bf_lo(xa.x), bf_hi(xa.x), bf_lo(xa.y), bf_hi(xa.y)} + va;
            *(f32x4*)(oo + off + 8 * D) = (f32x4){bf_lo(xc.x), bf_hi(xc.x), bf_lo(xc.y), bf_hi(xc.y)} + vc;
            xa = na; xc = nc; off = nxt;
            asm volatile("" ::: "memory");
        }
    }
};

__device__ __forceinline__ int rowmap(int kind, int n) {
    switch (kind) {
        case 1: return (n & ~255) + 128 * ((n >> 5) & 1) + 32 * ((n >> 6) & 3) + (n & 31);
        case 2: return 256 * (n >> 7) + (n & 127);
        case 3: return 256 * (n >> 7) + 128 + (n & 127);
        case 4: return 1024 + n;
        default: return n;
    }
}
__device__ __forceinline__ void tr_item(const float* W, int ldw, int col0, int K, bf16* WT, int kind, int nblk, LAS float* scr, int item, int lane, const float* ks0 = nullptr, const float* ks1 = nullptr) {
    const int kb = item / nblk, nb = item % nblk, k0 = 64 * kb, n0 = 32 * nb;
    const float* ks = ks0 ? (k0 < 512 ? ks0 + k0 : ks1 + (k0 - 512)) : nullptr;
#pragma unroll 8
    for (int i = 0; i < 32; ++i) { const int kk = 2 * i + (lane >> 5); scr[kk * 33 + (lane & 31)] = W[(size_t)(k0 + kk) * ldw + col0 + n0 + (lane & 31)] * (ks ? ks[kk] : 1.0f); }
    asm volatile("s_waitcnt lgkmcnt(0)" ::: "memory");
    const int c = lane & 7;
#pragma unroll
    for (int j = 0; j < 4; ++j) {
        const int n = (lane >> 3) + 8 * j; const LAS float* s = scr + (8 * c) * 33 + n;
        v4u o; o.x = cvt_pk_bf16(s[0 * 33], s[1 * 33]); o.y = cvt_pk_bf16(s[2 * 33], s[3 * 33]); o.z = cvt_pk_bf16(s[4 * 33], s[5 * 33]); o.w = cvt_pk_bf16(s[6 * 33], s[7 * 33]);
        *(v4u*)(WT + (size_t)rowmap(kind, n0 + n) * K + k0 + 8 * c) = o;
    }
    asm volatile("s_waitcnt lgkmcnt(0)" ::: "memory");
}

__device__ __forceinline__ void phase0(const Args& a, LAS unsigned char* lds, int tid, int lane, int wave, int bid, int G) {
    unsigned char* ws = a.ws;
    float* mod = (float*)(ws + WS_MOD);
    for (int task = bid; task < NMOD / 64; task += G) {
        LAS float* sc = (LAS float*)lds;
        LAS float* red = (LAS float*)(lds + 49152);
        for (int u = tid; u < 12 * 1024; u += 512) { const int b = u >> 10, i = u & 1023; const float c = b < 4 ? a.cp[b * 1024 + i] : a.cs[(b - 4) * 1024 + i]; sc[u] = c / (1.0f + __expf(-c)); }
        __syncthreads();
        const int j0 = task * 64;
        float acc[12];
#pragma unroll
        for (int b = 0; b < 12; ++b) acc[b] = 0.f;
        for (int ii = 0; ii < 128; ++ii) {
            const int i = wave * 128 + ii; const float w = a.w_ada[(size_t)i * NMOD + j0 + lane];
#pragma unroll
            for (int b = 0; b < 12; ++b) acc[b] += sc[b * 1024 + i] * w;
        }
#pragma unroll
        for (int b = 0; b < 12; ++b) red[(wave * 12 + b) * 64 + lane] = acc[b];
        __syncthreads();
        for (int u = tid; u < 768; u += 512) {
            const int b = u >> 6, col = u & 63; float s = a.b_ada[j0 + col];
#pragma unroll
            for (int w = 0; w < 8; ++w) s += red[(w * 12 + b) * 64 + col];
            mod[b * NMOD + j0 + col] = s;
        }
        __syncthreads();
    }
    {
        LAS float* scr = (LAS float*)(lds + wave * 16384);
        const int gw = bid * 8 + wave, NGW = G * 8;
        constexpr int I_QK = 16 * 32, I_V = 16 * 16, I_O = 16 * 32, I_G = 16 * 88, I_D = 44 * 32;
        constexpr int NITEMS = I_QK + I_V + I_O + 2 * I_G + I_D;
        for (int it = gw; it < NITEMS; it += NGW) {
            int r = it;
            if (r < I_QK) { tr_item(a.w_in, 2048, 512, 1024, (bf16*)(ws + WS_WQK), 1, 32, scr, r, lane); continue; } r -= I_QK;
            if (r < I_V) { tr_item(a.w_in, 2048, 1536, 1024, (bf16*)(ws + WS_WUV), 4, 16, scr, r, lane); continue; } r -= I_V;
            if (r < I_O) { tr_item(a.w_o, 1024, 0, 1024, (bf16*)(ws + WS_WO), 0, 32, scr, r, lane, a.g_fout, a.g_aout); continue; } r -= I_O;
            if (r < I_G) { tr_item(a.w_gate, DFF, 0, 1024, (bf16*)(ws + WS_WGU), 2, 88, scr, r, lane); continue; } r -= I_G;
            if (r < I_G) { tr_item(a.w_up, DFF, 0, 1024, (bf16*)(ws + WS_WGU), 3, 88, scr, r, lane); continue; } r -= I_G;
            tr_item(a.w_down, 1024, 0, DFF, (bf16*)(ws + WS_WD), 0, 32, scr, r, lane);
        }
    }
    {
        float* CS = (float*)(ws + WS_CS);
        for (int o = bid * 512 + tid; o < 2 * 4 * 128 * 128; o += G * 512) {
            const int d = o & 127, c = (o >> 7) & 127, g = (o >> 14) & 3, cs = o >> 16;
            float s = 0.f;
            for (int e = 0; e < 128; ++e) {
                const float ang = (float)((c * e) & 127) * (1.0f / 128.0f);
                const float t = cs ? __builtin_amdgcn_sinf(ang) : __builtin_amdgcn_cosf(ang);
                s += t * a.w_fmix[(g * 128 + e) * 128 + d];
            }
            CS[o] = s * 0.08838834764831845f;
        }
    }
    {
        bf16* DAS = (bf16*)(ws + WS_DAS); bf16* DAP = (bf16*)(ws + WS_DAP);
        for (int o = bid * 512 + tid; o < 65536 + 32768; o += G * 512) {
            float v = 0.f; bf16* dst;
            if (o < 65536) {
                const int r = o >> 8, k = o & 255, ri = r >> 7, k1 = r & 127, cs = k >> 7, t1 = k & 127;
                const float f = (float)((k1 * t1) & 127) * (1.0f / 128.0f), c = __builtin_amdgcn_cosf(f), sn = __builtin_amdgcn_sinf(f);
                v = (ri == 0 ? (cs == 0 ? c : -sn) : (cs == 0 ? -sn : -c)) * 0.08838834764831845f; dst = DAS + o;
            } else {
                const int o2 = o - 65536, r = o2 >> 7, k = o2 & 127, ri = r >> 7, rr = r & 127, cs = k >> 6, t1 = k & 63;
                if (rr < 64) { const float f = (float)((rr * t1) & 63) * (1.0f / 64.0f), c = __builtin_amdgcn_cosf(f), sn = __builtin_amdgcn_sinf(f);
                    v = (ri == 0 ? (cs == 0 ? c : -sn) : (cs == 0 ? -sn : -c)) * 0.125f; }
                dst = DAP + o2;
            }
            *dst = (bf16)(cvt_pk_bf16(v, 0.f) & 0xffffu);
        }
        for (int it = bid * 512 + tid; it < (128 + 64) * 256 * 16; it += G * 512) {
            const bool isS = it < 128 * 256 * 16; const int i2 = isS ? it : it - 128 * 256 * 16;
            const int row = i2 >> 4, k0 = (i2 & 15) * 8, k1 = row >> 8, r = row & 255, ri = k0 >> 6, t2 = k0 & 63;
            const int T1 = isS ? 128 : 64, T = 64 * T1, kk = k1 + T1 * r;
            float v[8];
#pragma unroll
            for (int e = 0; e < 8; ++e) { const float f = (float)((kk * (t2 + e)) & (T - 1)) * (1.0f / (float)T); v[e] = r < 64 ? (ri == 0 ? __builtin_amdgcn_cosf(f) : __builtin_amdgcn_sinf(f)) * 0.125f : 0.f; }
            v4u w; w.x = cvt_pk_bf16(v[0], v[1]); w.y = cvt_pk_bf16(v[2], v[3]); w.z = cvt_pk_bf16(v[4], v[5]); w.w = cvt_pk_bf16(v[6], v[7]);
            *(v4u*)((bf16*)(ws + (isS ? WS_DBS : WS_DBP)) + (size_t)row * 128 + k0) = w;
        }
    }
}

template <bool FROM_SSQ>
__device__ __forceinline__ void norm_rows(const Args& a, const float* xsrc_p, const float* xsrc_s, const float* g, int shift_off, int scale_off, const float* ssq, bf16* H, int lane, int gw, int NGW) {
    const float* mod = (const float*)(a.ws + WS_MOD);
    for (int ch = gw; ch < NTOK / 8; ch += NGW) {
        const int tok0 = ch * 8, b = batch_of(tok0);
        const float* mb = mod + b * NMOD;
        f32x4 gs[4], sh[4];
#pragma unroll
        for (int jj = 0; jj < 4; ++jj) {
            const int c = lane * 4 + 256 * jj;
            gs[jj] = *(const f32x4*)(g + c) * (*(const f32x4*)(mb + scale_off + c) + 1.0f);
            sh[jj] = *(const f32x4*)(mb + shift_off + c);
        }
        for (int tt = 0; tt < 8; ++tt) {
            const int tok = tok0 + tt;
            const float* xr = tok < NTOK_P ? xsrc_p + (size_t)tok * D : xsrc_s + (size_t)(tok - NTOK_P) * D;
            f32x4 v[4]; float ss = 0.f;
#pragma unroll
            for (int jj = 0; jj < 4; ++jj) { if (FROM_SSQ) { const v2u xw = *(const v2u*)((const bf16*)xsrc_p + (size_t)tok * D + lane * 4 + 256 * jj); v[jj] = (f32x4){bf_lo(xw.x), bf_hi(xw.x), bf_lo(xw.y), bf_hi(xw.y)}; } else v[jj] = *(const f32x4*)(xr + lane * 4 + 256 * jj); ss += (v[jj][0] * v[jj][0] + v[jj][1] * v[jj][1]) + (v[jj][2] * v[jj][2] + v[jj][3] * v[jj][3]); }
            float tot;
            if (FROM_SSQ) tot = ssq[tok]; else tot = wave_sum(ss);
            const float rstd = rsqrtf(tot * (1.0f / 1024.0f) + EPS);
#pragma unroll
            for (int jj = 0; jj < 4; ++jj) {
                const f32x4 o = v[jj] * rstd * gs[jj] + sh[jj];
                v2u w; w.x = cvt_pk_bf16(o[0], o[1]); w.y = cvt_pk_bf16(o[2], o[3]);
                *(v2u*)(H + (size_t)tok * D + lane * 4 + 256 * jj) = w;
            }
        }
    }
}

__device__ __forceinline__ void fold_uw(const Args& a, LAS unsigned char* lds, int tid, int bid, int G) {
    const float* CS = (const float*)(a.ws + WS_CS);
    bf16* WUV = (bf16*)(a.ws + WS_WUV);
    LAS float* Wt = (LAS float*)lds;
    LAS float* CSl = (LAS float*)(lds + 16384);
    for (int task = bid; task < 256; task += G) {
        const int cs = task >> 7, g = (task >> 5) & 3, i0 = (task & 31) * 32;
        for (int u = tid; u < 32 * 128; u += 512) { const int i = u >> 7, c = u & 127; Wt[u] = a.w_in[(size_t)(i0 + i) * 2048 + g * 128 + c]; }
        for (int u = tid; u < 128 * 128; u += 512) CSl[u] = CS[(size_t)(cs * 4 + g) * 16384 + u];
        __syncthreads();
        const int d = tid & 127, iq = tid >> 7;
        float acc[8];
#pragma unroll
        for (int ii = 0; ii < 8; ++ii) acc[ii] = 0.f;
        for (int c = 0; c < 128; ++c) {
            const float csv = CSl[c * 128 + d];
#pragma unroll
            for (int ii = 0; ii < 8; ++ii) acc[ii] += Wt[(iq * 8 + ii) * 128 + c] * csv;
        }
        v4u w; w.x = cvt_pk_bf16(acc[0], acc[1]); w.y = cvt_pk_bf16(acc[2], acc[3]); w.z = cvt_pk_bf16(acc[4], acc[5]); w.w = cvt_pk_bf16(acc[6], acc[7]);
        *(v4u*)(WUV + (size_t)(cs * 512 + g * 128 + d) * 1024 + i0 + iq * 8) = w;
        __syncthreads();
    }
}

constexpr int AT_ROWB = 144, AT_SLOT = 2 * 64 * AT_ROWB;
constexpr int AT_RPB_OFF = 40960, AT_SMAX_OFF = AT_RPB_OFF + 8 * 480 * 4;
__device__ __forceinline__ void attn_task(const Args& a, int task, LAS unsigned char* lds, int tid, int wave, int lane, const unsigned (&idxp)[4], const int mbits) {
    const bf16* Q = (const bf16*)(a.ws + WS_Q); const bf16* K = (const bf16*)(a.ws + WS_K); bf16* CAT = (bf16*)(a.ws + WS_CAT);
    float* ssqa = (float*)(a.ws + WS_SSQA);
    int h, i0, T, tok0, rows; const bf16* vt;
    if (task < 256) { const int seq = task >> 6; h = (task >> 3) & 7; i0 = (task & 7) * 8; T = TP; tok0 = seq * TP; rows = 64; vt = (const bf16*)(a.ws + WS_VTP) + (size_t)seq * 512 * TP; }
    else { const int t2 = task - 256, seq = t2 >> 7; h = (t2 >> 4) & 7; i0 = (t2 & 15) * 8; T = TS; tok0 = NTOK_P + seq * TS; rows = 128; vt = (const bf16*)(a.ws + WS_VTS) + (size_t)seq * 512 * TS; }
    const int q = lane & 15, g = lane >> 4, i = i0 + wave;
    const int rsw = min(max(i - 4, 0), rows - 8);
    const int kr_lo = min(max(i0 - 4, 0), rows - 8), kr_hi = min(max(i0 + 3, 0), rows - 8) + 7;
    const LAS unsigned char* tabh = lds + AT_RPB_OFF + h * 1920;
    const bf16* kg = K + (size_t)(tok0 + (tid >> 3)) * 512 + 64 * h + (tid & 7) * 8;
    const bf16* vg = vt + (size_t)(64 * h + (tid >> 3)) * T + (tid & 7) * 8;
    const int stoff = (tid >> 3) * AT_ROWB + (tid & 7) * 16;
    v4u kst[2], vst[2];
#pragma unroll
    for (int u = 0; u < 2; ++u) if (kr_lo + u <= kr_hi) { kst[u] = *(const v4u*)(kg + (size_t)(kr_lo + u) * 64 * 512); vst[u] = *(const v4u*)(vg + (kr_lo + u) * 64); }
    bf16x8 bq[4][2];
#pragma unroll
    for (int j = 0; j < 4; ++j) { const bf16* qp = Q + (size_t)(tok0 + i * 64 + 16 * j + q) * 512 + 64 * h + 8 * g; bq[j][0] = *(const bf16x8*)qp; bq[j][1] = *(const bf16x8*)(qp + 32); }
    f32x4 O[4][4]; float sum[4];
#pragma unroll
    for (int j = 0; j < 4; ++j) { sum[j] = 0.f;
#pragma unroll
        for (int db = 0; db < 4; ++db) O[j][db] = (f32x4){0.f, 0.f, 0.f, 0.f}; }
    *(LAS v4u*)(lds + (kr_lo & 1) * AT_SLOT + stoff) = kst[0]; *(LAS v4u*)(lds + (kr_lo & 1) * AT_SLOT + 64 * AT_ROWB + stoff) = vst[0];
    __syncthreads();
    for (int base = kr_lo; base <= kr_hi; base += 2) {
#pragma unroll
      for (int u = 0; u < 2; ++u) {
        const int kr = base + u;
        if (kr > kr_hi) break;
        if (kr + 2 <= kr_hi) { kst[u] = *(const v4u*)(kg + (size_t)(kr + 2) * 64 * 512); vst[u] = *(const v4u*)(vg + (kr + 2) * 64); }
        if (kr >= rsw && kr < rsw + 8) {
            const LAS unsigned char* Ks = lds + (kr & 1) * AT_SLOT; const LAS unsigned char* Vs = Ks + 64 * AT_ROWB;
            const LAS unsigned char* rb = tabh + (kr - i + 7) * 128;
            bf16x8 kf[2][4]; float tbv[2][4];
#define AT_LOADK(j_, buf_) do { const int kc0_ = ((j_) == 0) ? 0 : ((j_) == 1) ? 8 : ((j_) == 2) ? 24 : 32; \
                _Pragma("unroll") for (int cb = 0; cb < 2; ++cb) { const LAS unsigned char* kp = Ks + (kc0_ + 16 * cb + q) * AT_ROWB + 16 * g; \
                    kf[buf_][2 * cb] = *(const LAS bf16x8*)kp; kf[buf_][2 * cb + 1] = *(const LAS bf16x8*)(kp + 64); } \
                _Pragma("unroll") for (int e = 0; e < 4; ++e) tbv[buf_][e] = *(const LAS float*)(rb + ((idxp[j_] >> (8 * e)) & 0xffu)); } while (0)
            AT_LOADK(0, 0);
#pragma unroll
            for (int j = 0; j < 4; ++j) {
                const int kc0 = (j == 0) ? 0 : (j == 1) ? 8 : (j == 2) ? 24 : 32;
                const int cur = j & 1;
                v2u vlo[4], vhi[4];
#pragma unroll
                for (int db = 0; db < 4; ++db) { const LAS unsigned char* vp = Vs + (16 * db + q) * AT_ROWB + (kc0 + 4 * g) * 2; vlo[db] = *(const LAS v2u*)vp; vhi[db] = *(const LAS v2u*)(vp + 32); }
                if (j < 3) AT_LOADK(j + 1, cur ^ 1);
                __builtin_amdgcn_sched_barrier(0);
                f32x4 sv[2];
                __builtin_amdgcn_s_setprio(1);
#pragma unroll
                for (int cb = 0; cb < 2; ++cb) {
                    f32x4 z = {0.f, 0.f, 0.f, 0.f};
                    z = __builtin_amdgcn_mfma_f32_16x16x32_bf16(kf[cur][2 * cb], bq[j][0], z, 0, 0, 0);
                    z = __builtin_amdgcn_mfma_f32_16x16x32_bf16(kf[cur][2 * cb + 1], bq[j][1], z, 0, 0, 0);
                    sv[cb] = z;
                }
                __builtin_amdgcn_s_setprio(0);
                float ps = 0.f;
#pragma unroll
                for (int e = 0; e < 4; ++e) {
                    const bool v0 = (mbits >> (j * 4 + e)) & 1;
                    const float p = __builtin_amdgcn_exp2f((v0 ? sv[0][e] : sv[1][e]) + tbv[cur][e]);
                    sv[0][e] = v0 ? p : 0.f; sv[1][e] = v0 ? 0.f : p; ps += p;
                }
                sum[j] += ps;
                v4u pw; pw.x = cvt_pk_bf16(sv[0][0], sv[0][1]); pw.y = cvt_pk_bf16(sv[0][2], sv[0][3]); pw.z = cvt_pk_bf16(sv[1][0], sv[1][1]); pw.w = cvt_pk_bf16(sv[1][2], sv[1][3]);
                const bf16x8 pf = __builtin_bit_cast(bf16x8, pw);
                __builtin_amdgcn_s_setprio(1);
#pragma unroll
                for (int db = 0; db < 4; ++db) {
                    v4u w; w.x = vlo[db].x; w.y = vlo[db].y; w.z = vhi[db].x; w.w = vhi[db].y;
                    O[j][db] = __builtin_amdgcn_mfma_f32_16x16x32_bf16(__builtin_bit_cast(bf16x8, w), pf, O[j][db], 0, 0, 0);
                }
                __builtin_amdgcn_s_setprio(0);
            }
#undef AT_LOADK
        }
        if (kr < kr_hi) { *(LAS v4u*)(lds + ((kr + 1) & 1) * AT_SLOT + stoff) = kst[(u + 1) & 1]; *(LAS v4u*)(lds + ((kr + 1) & 1) * AT_SLOT + 64 * AT_ROWB + stoff) = vst[(u + 1) & 1]; }
        __syncthreads();
      }
    }
#pragma unroll
    for (int j = 0; j < 4; ++j) {
        float sm = sum[j]; sm += __shfl_xor(sm, 16); sm += __shfl_xor(sm, 32);
        const float inv = 1.0f / sm; float ss = 0.f;
        const int tok = tok0 + i * 64 + 16 * j + q;
        bf16* op = CAT + (size_t)tok * 1024 + 512 + 64 * h + 4 * g;
#pragma unroll
        for (int db = 0; db < 4; ++db) {
            const f32x4 o = O[j][db] * inv;
            ss += (o[0] * o[0] + o[1] * o[1]) + (o[2] * o[2] + o[3] * o[3]);
            v2u w; w.x = cvt_pk_bf16(o[0], o[1]); w.y = cvt_pk_bf16(o[2], o[3]);
            *(v2u*)(op + 16 * db) = w;
        }
        ss += __shfl_xor(ss, 16); ss += __shfl_xor(ss, 32);
        if (g == 0) unsafeAtomicAdd(ssqa + tok, ss);
    }
}

__device__ __forceinline__ void attn_phase(const Args& a, LAS unsigned char* lds, int tid, int lane, int wave, int bid, int G, int part_lo, int part_hi) {
    {
        LAS float* tb = (LAS float*)(lds + AT_RPB_OFF) + wave * 480;
        float mb = 0.f;
        for (int idx = lane; idx < 465; idx += 64) mb = fmaxf(mb, fabsf(a.rpb[wave * 465 + idx]));
        float mq = fabsf(a.g_q[lane]), mk = fabsf(a.g_k[lane]);
#pragma unroll
        for (int o = 1; o < 64; o <<= 1) { mb = fmaxf(mb, __shfl_xor(mb, o)); mq = fmaxf(mq, __shfl_xor(mq, o)); mk = fmaxf(mk, __shfl_xor(mk, o)); }
        const float smax = 8.0f * mq * mk + mb;
        for (int idx = lane; idx < 480; idx += 64) { const int dr = idx >> 5, dc = idx & 31; tb[idx] = dc < 31 ? (a.rpb[wave * 465 + dr * 31 + dc] - smax) * 1.4426950408889634f : -1e30f; }
    }
    int mbits = 0;
    unsigned idxp[4];
    {
        const int q = lane & 15, g = lane >> 4;
#pragma unroll
        for (int j = 0; j < 4; ++j) {
            const int kc0 = (j == 0) ? 0 : (j == 1) ? 8 : (j == 2) ? 24 : 32;
            const int c = 16 * j + q, cst = min(max(c - 8, 0), 48);
            unsigned pk = 0u;
#pragma unroll
            for (int e = 0; e < 4; ++e) {
                const int k0c = kc0 + 4 * g + e, k1c = k0c + 16; const bool ok0 = (unsigned)(k0c - cst) < 16u;
                pk |= (unsigned)(((ok0 ? k0c : k1c) - c + 15) * 4) << (8 * e); mbits |= (ok0 ? 1 : 0) << (j * 4 + e);
            }
            idxp[j] = pk;
        }
    }
    __syncthreads();
    const int per = (1280 + G - 1) / G, r0 = bid * per, r1 = min(1280, r0 + per);
    for (int t = r0 + part_lo; t < min(r1, r0 + part_hi); ++t) attn_task(a, t, lds, tid, wave, lane, idxp, mbits);
    __syncthreads();
}

#define XB_TMO      128
#define XB_XCNT(j)  (256  + 64 * (j))
#define XB_XSUB(j)  (1280 + 64 * (j))
#define XB_XGEN(j)  (2304 + 64 * (j))
#define XB_TOP      3328
#define XB_TOPGEN   3392
#define XCD_BAR_WORDS 3456
#define XB_SPIN_CAP (1u << 18)

__device__ __forceinline__ unsigned xb_ld(unsigned* p)              { return __hip_atomic_load(p, __ATOMIC_RELAXED, __HIP_MEMORY_SCOPE_AGENT); }
__device__ __forceinline__ unsigned xb_add(unsigned* p, unsigned v) { return __hip_atomic_fetch_add(p, v, __ATOMIC_RELAXED, __HIP_MEMORY_SCOPE_AGENT); }
__device__ __forceinline__ unsigned xb_xcc_id() { return (unsigned)__builtin_amdgcn_s_getreg((3 << 11) | 20) & 0xFu; }
#define XB_SPIN(cond, bar) do { unsigned _sp = 0; while (cond) { __builtin_amdgcn_s_sleep(1); \
    if ((++_sp & 255u) == 0u) { if (xb_ld(&(bar)[XB_TMO])) break; if (_sp > XB_SPIN_CAP) { atomicAdd(&(bar)[XB_TMO], 1u); break; } } } } while (0)

struct XcdBarrier {
    unsigned* bar; unsigned x;
    volatile LAS unsigned* st;
};

__device__ __forceinline__ XcdBarrier xcd_barrier_post(unsigned* bar, volatile LAS unsigned* st) {
    XcdBarrier b; b.bar = bar; b.x = xb_xcc_id(); b.st = st;
    if (threadIdx.x == 0) (void)xb_add(&bar[XB_XCNT(b.x)], 1u);
    return b;
}
__device__ __forceinline__ void xcd_barrier_complete(unsigned* bar, unsigned x, unsigned& nloc, unsigned& nx) {
    const unsigned G = gridDim.x * gridDim.y * gridDim.z;
    unsigned sum, cnt, mine, sp = 0u;
    for (;;) {
        sum = 0u; cnt = 0u; mine = 0u;
#pragma unroll
        for (unsigned j = 0; j < 16; ++j) { const unsigned c = xb_ld(&bar[XB_XCNT(j)]); sum += c; cnt += (c > 0u) ? 1u : 0u; mine = (j == x) ? c : mine; }
        if (sum == G) break;
        __builtin_amdgcn_s_sleep(1);
        if ((++sp & 255u) == 0u) { if (xb_ld(&bar[XB_TMO])) break; if (sp > XB_SPIN_CAP) { atomicAdd(&bar[XB_TMO], 1u); break; } }
    }
    nloc = mine > 0u ? mine : 1u; nx = cnt > 0u ? cnt : 1u;
}

__device__ __forceinline__ void xcd_barrier(const XcdBarrier& b) {
    asm volatile("s_waitcnt vmcnt(0)" ::: "memory");
    __syncthreads();
    if (threadIdx.x == 0) {
        unsigned* bar = b.bar;
        __builtin_amdgcn_s_waitcnt(0);
        unsigned nloc = b.st[0], nx = b.st[1];
        if (nloc == 0u) { xcd_barrier_complete(bar, b.x, nloc, nx); b.st[0] = nloc; b.st[1] = nx; }
        const unsigned old = xb_add(&bar[XB_XSUB(b.x)], 1u);
        const unsigned gen = old / nloc;
        if (old + 1u == (gen + 1u) * nloc) {
            __builtin_amdgcn_fence(__ATOMIC_RELEASE, "agent");
            asm volatile("s_waitcnt vmcnt(0)" ::: "memory");
            const unsigned og = xb_add(&bar[XB_TOP], 1u);
            const unsigned tg = og / nx;
            if (og + 1u == (tg + 1u) * nx) xb_add(&bar[XB_TOPGEN], 1u);
            else XB_SPIN(xb_ld(&bar[XB_TOPGEN]) == tg, bar);
            __builtin_amdgcn_fence(__ATOMIC_ACQUIRE, "agent");
            xb_add(&bar[XB_XGEN(b.x)], 1u);
            asm volatile("s_waitcnt vmcnt(0)" ::: "memory");
        } else {
            XB_SPIN(xb_ld(&bar[XB_XGEN(b.x)]) == gen, bar);
            __builtin_amdgcn_fence(__ATOMIC_ACQUIRE, "agent");
            asm volatile("s_waitcnt vmcnt(0)" ::: "memory");
        }
    }
    __syncthreads();
}

__global__ void __launch_bounds__(512, 2) fwd_mega(Args a) {
    extern __shared__ __attribute__((aligned(16))) unsigned char lds_raw[];
    LAS unsigned char* lds = (LAS unsigned char*)lds_raw;
    cg::grid_group grid = cg::this_grid();
    const int tid = threadIdx.x, lane = tid & 63, wave = __builtin_amdgcn_readfirstlane(tid >> 6), bid = blockIdx.x, G = gridDim.x;
    const int gw = bid * 8 + wave, NGW = G * 8;
    unsigned char* ws = a.ws;
    const int lo = a.ph_lo, hi = a.ph_hi;
    volatile LAS unsigned* bst = (volatile LAS unsigned*)(lds + 131072 + 256);
    if (tid < 2) bst[tid] = 0u;
    __syncthreads();
    const XcdBarrier bar = xcd_barrier_post((unsigned*)(ws + WS_BAR), bst);
#define IN(k) (lo <= (k) && (k) < hi)
#define SEAM(k) do { if (IN(k) && IN((k) + 1)) xcd_barrier(bar); } while (0)
    if (hi < 0) grid.sync();

    if (IN(0)) phase0(a, lds, tid, lane, wave, bid, G);
    SEAM(0);
    if (IN(1)) {
        fold_uw(a, lds, tid, bid, G);
        norm_rows<false>(a, a.xp, a.xs, a.g_attn, 0, 1024, nullptr, (bf16*)(ws + WS_H), lane, gw, NGW);
    }
    SEAM(1);
    if (IN(2)) {
        { pg8::Gemm g{(const bf16*)(ws + WS_H), (const bf16*)(ws + WS_WQK), NTOK, 1024, 1024}; pg8::StaticOrder S; S.init(NTOK, 1024, G, bid);
          EpiQK E{(bf16*)(ws + WS_Q), (bf16*)(ws + WS_K), a.g_q, a.g_k};
          pg8::gemm_phase<EpiQK, pg8::StaticOrder, true, true>(lds, g, S, E); }
        { pg8::Gemm g{(const bf16*)(ws + WS_WUV), (const bf16*)(ws + WS_H), 1024, NTOK_S, 1024}; UOrder<128> S{G, bid, NTOK_S / 256, NTOK_P};
          EpiU<128> E{(bf16*)(ws + WS_UTS)};
          pg8::gemm_phase<EpiU<128>, UOrder<128>, true, true>(lds, g, S, E); }
        { pg8::Gemm g{(const bf16*)(ws + WS_WUV), (const bf16*)(ws + WS_H), 1024, NTOK_P, 1024}; UOrder<64> S{G, bid, NTOK_P / 256, 0};
          EpiU<64> E{(bf16*)(ws + WS_UTP)};
          pg8::gemm_phase<EpiU<64>, UOrder<64>, true, true>(lds, g, S, E); }
        { pg8::Gemm g{(const bf16*)(ws + WS_WUV) + (size_t)1024 * 1024, (const bf16*)(ws + WS_H), 512, NTOK, 1024}; pg8::StaticOrder S; S.init(512, NTOK, G, bid);
          EpiV E{ws};
          pg8::gemm_phase<EpiV, pg8::StaticOrder, true, true>(lds, g, S, E); }
    }
    SEAM(2);
    if (IN(3)) {
        int k256 = 256, k128 = 128; asm volatile("" : "+s"(k256), "+s"(k128));
        int zm = 0; asm volatile("" : "+s"(zm));
        if (bid & 1) attn_phase(a, lds, tid, lane, wave, bid, G, 0, AT_SPLIT);
        { pg8::Gemm g{(const bf16*)(ws + WS_DAS), (const bf16*)(ws + WS_UTS), 256, 8 * 512 * 64, k256}; RowOrder S{G, bid, 8 * 512 * 64 / 256, 0, zm};
          EpiA<128> E{(bf16*)(ws + WS_YS)};
          pg8::gemm_phase<EpiA<128>, RowOrder, true, true>(lds, g, S, E); }
        { pg8::Gemm g{(const bf16*)(ws + WS_DAP), (const bf16*)(ws + WS_UTP), 256, 4 * 512 * 64, k128}; RowOrder S{G, bid, 4 * 512 * 64 / 256, 0, zm};
          EpiA<64> E{(bf16*)(ws + WS_YP)};
          pg8::gemm_phase<EpiA<64>, RowOrder, true, true>(lds, g, S, E); }
        if (!(bid & 1)) attn_phase(a, lds, tid, lane, wave, bid, G, 0, AT_SPLIT);
    }
    SEAM(3);
    if (IN(4)) {   int k128 = 128; asm volatile("" : "+s"(k128));
        if (bid & 1) attn_phase(a, lds, tid, lane, wave, bid, G, AT_SPLIT, 1 << 20);
        { pg8::Gemm g{(const bf16*)(ws + WS_DBS), (const bf16*)(ws + WS_YS), 128 * 256, 8 * 128 * 512, k128}; RowOrder S{G, bid, 8 * 128 * 512 / 256, 1, 127};
          EpiB<128> E{(bf16*)(ws + WS_CAT), (float*)(ws + WS_SSQF), NTOK_P};
          pg8::gemm_phase<EpiB<128>, RowOrder, true, true>(lds, g, S, E); }
        { pg8::Gemm g{(const bf16*)(ws + WS_DBP), (const bf16*)(ws + WS_YP), 64 * 256, 4 * 64 * 512, k128}; RowOrder S{G, bid, 4 * 64 * 512 / 256, 1, 63};
          EpiB<64> E{(bf16*)(ws + WS_CAT), (float*)(ws + WS_SSQF), 0};
          pg8::gemm_phase<EpiB<64>, RowOrder, true, true>(lds, g, S, E); }
        if (!(bid & 1)) attn_phase(a, lds, tid, lane, wave, bid, G, AT_SPLIT, 1 << 20);
    }
    SEAM(4);
    if (IN(5)) {
        pg8::Gemm g{(const bf16*)(ws + WS_CAT), (const bf16*)(ws + WS_WO), NTOK, 1024, 1024}; pg8::StaticOrder S; S.init(NTOK, 1024, G, bid);
        LAS float* rs = (LAS float*)(lds + 131072 + 1024);
        { const float* sf = (const float*)(ws + WS_SSQF); const float* sa = (const float*)(ws + WS_SSQA); Unit uu;
          for (int i = 0; i < 7 && S.next(i, uu); ++i) if (tid < 256) { const int tok = uu.pm * 256 + tid;
              const float qa = sa[tok] * (1.0f / 512.0f) + EPS, qf = sf[tok] * (1.0f / 512.0f) + EPS; rs[i * 512 + 2 * tid] = sqrtf(qa / qf); rs[i * 512 + 2 * tid + 1] = rsqrtf(qa); }
          __syncthreads(); }
        EpiWo E{a.xp, a.xs, (bf16*)(ws + WS_XB), (const float*)(ws + WS_MOD), (float*)(ws + WS_SSQ), rs};
        pg8::gemm_phase<EpiWo, pg8::StaticOrder, true, true>(lds, g, S, E);
    }
    SEAM(5);
    if (IN(6)) norm_rows<true>(a, (const float*)(ws + WS_XB), nullptr, a.g_ffn, 3072, 4096, (const float*)(ws + WS_SSQ), (bf16*)(ws + WS_H), lane, gw, NGW);
    SEAM(6);
    if (IN(7)) {
        pg8::Gemm g{(const bf16*)(ws + WS_H), (const bf16*)(ws + WS_WGU), NTOK, 2 * DFF, 1024}; pg8::StaticOrder S; S.init(NTOK, 2 * DFF, G, bid);
        EpiUp E{(bf16*)(ws + WS_HID)};
        pg8::gemm_phase<EpiUp, pg8::StaticOrder, true, true>(lds, g, S, E);
    }
    SEAM(7);
    if (IN(8)) {
        pg8::Gemm g{(const bf16*)(ws + WS_HID), (const bf16*)(ws + WS_WD), NTOK, 1024, DFF}; pg8::StaticOrder S; S.init(NTOK, 1024, G, bid);
        EpiDown E{a.out, (const bf16*)(ws + WS_XB), (const float*)(ws + WS_MOD), (LAS float*)(lds + 131072 + 1024)};
        pg8::gemm_phase<EpiDown, pg8::StaticOrder, true, true>(lds, g, S, E);
    }
#undef IN
#undef SEAM
}

#ifndef MK_N_LAUNCHES
#define MK_N_LAUNCHES 1
#endif
extern "C" void kernel_launch(void* const* d_in, const int* in_sizes, int n_in, void* d_out, int out_size, void* d_ws, size_t ws_size, hipStream_t stream) {
    static int grid = 0;
    if (grid == 0) {
        if (n_in != 19 || out_size != NTOK * D || ws_size < WS_END) { fprintf(stderr, "kernel_launch: unexpected shapes (n_in %d, out %d, ws %zu)\n", n_in, out_size, ws_size); grid = -1; return; }
        int dev = 0, cus = 0, per_cu = 0;
        hipGetDevice(&dev); hipDeviceGetAttribute(&cus, hipDeviceAttributeMultiprocessorCount, dev);
        if (hipFuncSetAttribute((const void*)fwd_mega, hipFuncAttributeMaxDynamicSharedMemorySize, LDS_BYTES) != hipSuccess) { fprintf(stderr, "kernel_launch: hipFuncSetAttribute failed\n"); grid = -1; return; }
        hipOccupancyMaxActiveBlocksPerMultiprocessor(&per_cu, (const void*)fwd_mega, 512, LDS_BYTES);
        (void)hipGetLastError();
        if (per_cu < 1) { fprintf(stderr, "kernel_launch: occupancy query says %d blocks per CU\n", per_cu); per_cu = 1; }
        grid = cus;
    }
    if (grid < 0) return;
    hipMemsetAsync((char*)d_ws + WS_SSQ, 0, 1 * MiB, stream);
    Args a{};
    a.xp = (const float*)d_in[0]; a.xs = (const float*)d_in[1]; a.cp = (const float*)d_in[2]; a.cs = (const float*)d_in[3]; a.w_ada = (const float*)d_in[4]; a.b_ada = (const float*)d_in[5];
    a.g_attn = (const float*)d_in[6]; a.w_in = (const float*)d_in[7]; a.g_q = (const float*)d_in[8]; a.g_k = (const float*)d_in[9]; a.w_fmix = (const float*)d_in[10]; a.rpb = (const float*)d_in[11];
    a.g_fout = (const float*)d_in[12]; a.g_aout = (const float*)d_in[13]; a.w_o = (const float*)d_in[14]; a.g_ffn = (const float*)d_in[15]; a.w_gate = (const float*)d_in[16]; a.w_up = (const float*)d_in[17];
    a.w_down = (const float*)d_in[18]; a.out = (float*)d_out; a.ws = (unsigned char*)d_ws;
#if MK_N_LAUNCHES == 1
    a.ph_lo = 0; a.ph_hi = 9;
    void* args[] = {&a};
    hipError_t e = hipLaunchCooperativeKernel((const void*)fwd_mega, dim3(grid), dim3(512), args, LDS_BYTES, stream);
    if (e != hipSuccess) fprintf(stderr, "kernel_launch: cooperative launch failed: %s (grid %d)\n", hipGetErrorString(e), grid);
#else
    for (int p = 0; p < 9; ++p) { a.ph_lo = p; a.ph_hi = p + 1; hipLaunchKernelGGL(fwd_mega, dim3(grid), dim3(512), LDS_BYTES, stream, a); }
#endif
}
```

```cpp
#include <hip/hip_runtime.h>
#include <hip/hip_cooperative_groups.h>
#include <cstdio>
#include <cstdint>
namespace cg = cooperative_groups;

namespace pg8 {
#define PG8_LAS __attribute__((address_space(3)))
typedef unsigned short bf16_t;
typedef short bf16x8 __attribute__((ext_vector_type(8)));
typedef float f32x4 __attribute__((ext_vector_type(4)));
typedef unsigned u32x4 __attribute__((ext_vector_type(4)));
constexpr int BM = 256, BK = 64, HALF = 128, HTB = HALF * BK * 2  , STAGE_BYTES = 8 * HTB, NXCD = 8, WGM = 4;

__host__ __device__ __forceinline__ int lds_byte(int r, int c) { const int st = (r >> 4) * 2 + (c >> 5), rr = r & 15, cc = c & 31, ob = rr * 64 + cc * 2; return st * 1024 + (ob ^ (((ob >> 9) & 1) << 5)); }
__host__ __device__ __forceinline__ void stage_rc(int b, int& R, int& C) { const int st = b / 1024, sb = b % 1024, swz = sb ^ (((sb >> 9) & 1) << 5); R = (st >> 1) * 16 + swz / 64; C = (st & 1) * 32 + (swz % 64) / 2; }
__host__ __device__ __forceinline__ int perm32(int rho) { const int n = rho >> 4, i = rho & 15; return 8 * (i >> 2) + 4 * n + (i & 3); }

struct Unit { int pm, pn; };
struct Gemm { const bf16_t* A; const bf16_t* Bt; int M, N, K; };

struct StaticOrder {
    static constexpr bool CUSTOMB = false, CUSTOMA = false;
    int nM, nN, nwg, G, c;
    __host__ __device__ void init(int M, int N, int G_, int c_) { nM = M / BM; nN = N / BM; nwg = nM * nN; G = G_; c = c_; }
    __host__ __device__ bool next(int i, Unit& u) const {
        const long L = (long)i * G + c; if (L >= nwg) return false;
        int wgid = (int)L; { const int q = nwg / NXCD, r = nwg % NXCD, xcd = wgid % NXCD, off = wgid / NXCD; wgid = (xcd < r ? xcd * (q + 1) : r * (q + 1) + (xcd - r) * q) + off; }
        const int nig = WGM * nN, gid = wgid / nig, fm = gid * WGM, gsz = (nM - fm) < WGM ? (nM - fm) : WGM;
        u.pm = fm + ((wgid % nig) % gsz); u.pn = (wgid % nig) / gsz; return true;
    }
    __device__ __forceinline__ void a_ready(const Unit&) const {}
    __device__ __forceinline__ void done(const Unit&) const {}
};

__device__ __forceinline__ unsigned cvt_pk_bf16(float lo, float hi) { unsigned r; asm volatile("v_cvt_pk_bf16_f32 %0, %1, %2" : "=v"(r) : "v"(lo), "v"(hi)); return r; }
template <class Epi, class Sched, bool ALIGN_EPI = false, bool SP2 = false>
__device__ __forceinline__ void gemm_phase(PG8_LAS unsigned char* lds, const Gemm g, const Sched& S, const Epi& E) {
    const int tid = threadIdx.x, wid = __builtin_amdgcn_readfirstlane(tid >> 6), lane = tid & 63, wr = wid >> 2, wc = wid & 3, fr = lane & 15, fq = lane >> 4;
    const int K = g.K, nt = K / BK;
    unsigned voffA[2], voffB[2];
#pragma unroll
    for (int i = 0; i < 2; ++i) { int R, C; stage_rc(tid * 16 + i * 8192, R, C); const int Rb = Epi::PERM ? ((R & ~31) + perm32(R & 31)) : R;
        if constexpr (Sched::CUSTOMA) voffA[i] = S.a_voff(R, C); else voffA[i] = (unsigned)(R * K + C) * 2u; if constexpr (Sched::CUSTOMB) voffB[i] = S.b_voff(Rb, C, K); else voffB[i] = (unsigned)(Rb * K + C) * 2u; }
    const size_t kstep = (size_t)(BK * 2);
    const size_t hstep = (size_t)HALF * K * 2;
    const size_t tstep = 2 * hstep;
    size_t hstepB = hstep; if constexpr (Sched::CUSTOMB) hstepB = S.b_hstep(K);
    size_t hstepA = hstep, kstepA = kstep; if constexpr (Sched::CUSTOMA) { hstepA = S.a_hstep(); kstepA = S.a_kstep(); }
    const unsigned ldsw = (unsigned)wid * 1024u;
    const int aoff = lds_byte(wr * 64 + fr, fq * 8), boff = lds_byte(wc * 32 + fr, fq * 8);
#define PG8_SA(b, h) (((b) * 2 + (h)) * HTB)
#define PG8_SB(b, h) ((4 + (b) * 2 + (h)) * HTB)
#define PG8_STAGE(bufoff, gbase, voff) do { _Pragma("unroll") for (int _i = 0; _i < 2; ++_i) \
        __builtin_amdgcn_global_load_lds((const unsigned*)((const char*)(gbase) + (voff)[_i]), (PG8_LAS unsigned*)(lds + (bufoff) + ldsw + _i * 8192), 16, 0, 0); } while (0)
#define PG8_LDA(dst, b, h) do { _Pragma("unroll") for (int m = 0; m < 4; ++m) _Pragma("unroll") for (int k = 0; k < 2; ++k) dst[m][k] = *(const PG8_LAS bf16x8*)(lds + PG8_SA(b, h) + aoff + m * 2048 + k * 1024); } while (0)
#define PG8_LDB(dst, b, h) do { _Pragma("unroll") for (int n = 0; n < 2; ++n) _Pragma("unroll") for (int k = 0; k < 2; ++k) dst[n][k] = *(const PG8_LAS bf16x8*)(lds + PG8_SB(b, h) + boff + n * 2048 + k * 1024); } while (0)
#define PG8_MMA(ai, bj, At, Bt) do { __builtin_amdgcn_s_setprio(1); _Pragma("unroll") for (int m = 0; m < 4; ++m) _Pragma("unroll") for (int n = 0; n < 2; ++n) _Pragma("unroll") for (int k = 0; k < 2; ++k) \
        acc[ai][bj][m][n] = __builtin_amdgcn_mfma_f32_16x16x32_bf16(Bt[n][k], At[m][k], acc[ai][bj][m][n], 0, 0, 0); __builtin_amdgcn_s_setprio(0); } while (0)
#define PG8_WAIT_V(n) asm volatile("s_waitcnt vmcnt(" #n ")" ::: "memory")
#define PG8_WAIT_L(n) asm volatile("s_waitcnt lgkmcnt(" #n ")" ::: "memory")
#define PG8_BAR __builtin_amdgcn_s_barrier()
#define PG8_SCHED __builtin_amdgcn_sched_barrier(0)
    Unit cur, nxt; int ui = 0;
    if (!S.next(0, cur)) return;
    f32x4 acc[2][2][4][2];
#pragma unroll
    for (int a = 0; a < 2; ++a)
#pragma unroll
        for (int b = 0; b < 2; ++b)
#pragma unroll
            for (int m = 0; m < 4; ++m)
#pragma unroll
                for (int n = 0; n < 2; ++n) acc[a][b][m][n] = (f32x4){0.f, 0.f, 0.f, 0.f};
    bf16x8 At[4][2], B0[2][2], B1[2][2];
    const char* cA; if constexpr (Sched::CUSTOMA) cA = (const char*)g.A + S.a_off(cur.pm); else cA = (const char*)g.A + (size_t)cur.pm * tstep; const char* cB; if constexpr (Sched::CUSTOMB) cB = (const char*)g.Bt + S.b_off(cur.pn, K); else cB = (const char*)g.Bt + (size_t)cur.pn * tstep;
    S.a_ready(cur);
    if constexpr (SP2) {
        PG8_STAGE(PG8_SB(0, 0), cB, voffB); PG8_STAGE(PG8_SB(0, 1), cB + hstepB, voffB); PG8_STAGE(PG8_SA(0, 0), cA, voffA); PG8_STAGE(PG8_SA(0, 1), cA + hstepA, voffA);
        if (wr == 1) PG8_BAR;
        PG8_WAIT_V(2); PG8_BAR;
        PG8_STAGE(PG8_SB(1, 0), cB + kstep, voffB); PG8_STAGE(PG8_SA(1, 0), cA + kstepA, voffA); PG8_STAGE(PG8_SB(1, 1), cB + hstepB + kstep, voffB);
        PG8_WAIT_V(6); PG8_BAR;
    } else {
        PG8_STAGE(PG8_SB(0, 0), cB, voffB); PG8_STAGE(PG8_SA(0, 0), cA, voffA); PG8_STAGE(PG8_SB(0, 1), cB + hstepB, voffB); PG8_STAGE(PG8_SA(0, 1), cA + hstepA, voffA);
        if (wr == 1) PG8_BAR;
        PG8_WAIT_V(4); PG8_BAR;
        PG8_STAGE(PG8_SB(1, 0), cB + kstep, voffB); PG8_STAGE(PG8_SA(1, 0), cA + kstepA, voffA); PG8_STAGE(PG8_SB(1, 1), cB + hstepB + kstep, voffB);
        PG8_WAIT_V(6); PG8_BAR;
    }
    for (;;) {
        const bool has_next = S.next(ui + 1, nxt);
        const char* nA; if constexpr (Sched::CUSTOMA) nA = has_next ? (const char*)g.A + S.a_off(nxt.pm) : cA; else nA = has_next ? (const char*)g.A + (size_t)nxt.pm * tstep : cA; const char* nB; if constexpr (Sched::CUSTOMB) nB = has_next ? (const char*)g.Bt + S.b_off(nxt.pn, K) : cB; else nB = has_next ? (const char*)g.Bt + (size_t)nxt.pn * tstep : cB;
        for (int seg = 0; seg < (Epi::MIDK ? 2 : 1); ++seg) {
        int t_lo = 0, t_hi = nt;
        if constexpr (Epi::MIDK) { if (seg == 0) t_hi = Epi::MIDT; else { t_lo = Epi::MIDT; E.mid(acc, ui, wr, wc, fr, fq); } }
        for (int t = t_lo; t < t_hi; t += 2) {
            const bool last = (t == nt - 2);
            const char* a1 = cA + (size_t)(t + 1) * kstepA;
            const char* a2 = last ? nA : cA + (size_t)(t + 2) * kstepA; const char* b2 = last ? nB : cB + (size_t)(t + 2) * kstep;
            const char* a3 = a2 + kstepA; const char* b3 = b2 + kstep;
            if (last && has_next) S.a_ready(nxt);
            if constexpr (SP2) {
            PG8_LDB(B0, 0, 0); PG8_LDB(B1, 0, 1); PG8_SCHED; PG8_LDA(At, 0, 0); PG8_STAGE(PG8_SA(1, 1), a1 + hstepA, voffA);
            PG8_WAIT_V(8); PG8_WAIT_L(0); PG8_BAR; PG8_MMA(0, 0, At, B0); PG8_MMA(0, 1, At, B1); PG8_BAR; PG8_SCHED;
            PG8_LDA(At, 0, 1); PG8_STAGE(PG8_SB(0, 0), b2, voffB); PG8_STAGE(PG8_SB(0, 1), b2 + hstepB, voffB); PG8_STAGE(PG8_SA(0, 0), a2, voffA);
            PG8_WAIT_V(8); PG8_WAIT_L(0); PG8_BAR; PG8_MMA(1, 0, At, B0); PG8_MMA(1, 1, At, B1); PG8_BAR; PG8_SCHED;
            PG8_LDB(B0, 1, 0); PG8_LDB(B1, 1, 1); PG8_SCHED; PG8_LDA(At, 1, 0); PG8_STAGE(PG8_SA(0, 1), a2 + hstepA, voffA);
            PG8_WAIT_V(8); PG8_WAIT_L(0); PG8_BAR; PG8_MMA(0, 0, At, B0); PG8_MMA(0, 1, At, B1); PG8_BAR; PG8_SCHED;
            PG8_LDA(At, 1, 1); PG8_STAGE(PG8_SB(1, 0), b3, voffB); PG8_STAGE(PG8_SB(1, 1), b3 + hstepB, voffB); PG8_STAGE(PG8_SA(1, 0), a3, voffA);
            PG8_WAIT_V(8); PG8_WAIT_L(0); PG8_BAR; PG8_MMA(1, 0, At, B0); PG8_MMA(1, 1, At, B1); PG8_BAR; PG8_SCHED;
            } else {
            PG8_LDB(B0, 0, 0); PG8_SCHED; PG8_LDA(At, 0, 0); PG8_STAGE(PG8_SA(1, 1), a1 + hstepA, voffA);
            PG8_WAIT_L(8); PG8_BAR; PG8_WAIT_L(0); PG8_MMA(0, 0, At, B0); PG8_BAR; PG8_SCHED;
            PG8_LDB(B1, 0, 1); PG8_STAGE(PG8_SB(0, 0), b2, voffB);
            PG8_BAR; PG8_WAIT_L(0); PG8_MMA(0, 1, At, B1); PG8_BAR;
            PG8_LDA(At, 0, 1); PG8_STAGE(PG8_SA(0, 0), a2, voffA);
            PG8_BAR; PG8_WAIT_L(0); PG8_MMA(1, 0, At, B0); PG8_BAR; PG8_SCHED;
            PG8_STAGE(PG8_SB(0, 1), b2 + hstepB, voffB);
            PG8_WAIT_V(6); PG8_BAR; PG8_MMA(1, 1, At, B1); PG8_BAR;
            PG8_LDB(B0, 1, 0); PG8_SCHED; PG8_LDA(At, 1, 0); PG8_STAGE(PG8_SA(0, 1), a2 + hstepA, voffA);
            PG8_WAIT_L(8); PG8_BAR; PG8_WAIT_L(0); PG8_MMA(0, 0, At, B0); PG8_BAR; PG8_SCHED;
            PG8_LDB(B1, 1, 1); PG8_STAGE(PG8_SB(1, 0), b3, voffB);
            PG8_BAR; PG8_WAIT_L(0); PG8_MMA(0, 1, At, B1); PG8_BAR;
            PG8_LDA(At, 1, 1); PG8_STAGE(PG8_SA(1, 0), a3, voffA);
            PG8_BAR; PG8_WAIT_L(0); PG8_MMA(1, 0, At, B0); PG8_BAR; PG8_SCHED;
            PG8_STAGE(PG8_SB(1, 1), b3 + hstepB, voffB);
            PG8_WAIT_V(6); PG8_BAR; PG8_MMA(1, 1, At, B1); PG8_BAR;
            }
        }
        }
        if constexpr (ALIGN_EPI) { if (wr == 0) PG8_BAR; }
        if constexpr (!Epi::AFTER_DRAIN) { if constexpr (Epi::MIDK) E.fin(acc, cur, ui, wr, wc, fr, fq); else E(acc, cur, wr, wc, fr, fq); S.done(cur); }
        if (!has_next) break;
#pragma unroll
        for (int a = 0; a < 2; ++a)
#pragma unroll
            for (int b = 0; b < 2; ++b)
#pragma unroll
                for (int m = 0; m < 4; ++m)
#pragma unroll
                    for (int n = 0; n < 2; ++n) acc[a][b][m][n] = (f32x4){0.f, 0.f, 0.f, 0.f};
        cur = nxt; cA = nA; cB = nB; ++ui;
        if constexpr (ALIGN_EPI) { if (wr == 1) PG8_BAR; }
    }
    PG8_WAIT_V(0);
    if constexpr (!ALIGN_EPI) { if (wr == 0) PG8_BAR; }
    PG8_BAR;
    if constexpr (Epi::AFTER_DRAIN) { E.fused(acc, cur, wr, wc, fr, fq, lds, wid, lane); S.done(cur); }
#undef PG8_SA
#undef PG8_SB
#undef PG8_STAGE
#undef PG8_LDA
#undef PG8_LDB
#undef PG8_MMA
#undef PG8_WAIT_V
#undef PG8_WAIT_L
#undef PG8_BAR
#undef PG8_SCHED
}
}

#define GAS __attribute__((address_space(1)))
#define LAS __attribute__((address_space(3)))
typedef unsigned short bf16;
typedef unsigned v4u __attribute__((ext_vector_type(4)));
typedef unsigned v2u __attribute__((ext_vector_type(2)));
typedef float f32x4 __attribute__((ext_vector_type(4)));
typedef short bf16x8 __attribute__((ext_vector_type(8)));
using pg8::Unit;
using pg8::cvt_pk_bf16;

constexpr int D = 1024, TP = 4096, TS = 8192, NTOK_P = 4 * TP, NTOK_S = 8 * TS, NTOK = NTOK_P + NTOK_S;
constexpr int DFF = 2816, NMOD = 6144;
constexpr float EPS = 1e-6f;
constexpr size_t MiB = 1u << 20;
constexpr size_t WS_SSQ = 0;
constexpr size_t WS_SSQA = 320 * 1024;
constexpr size_t WS_SSQF = 640 * 1024;
constexpr size_t WS_BAR = 960 * 1024;
constexpr size_t WS_MOD = 1 * MiB;
constexpr size_t WS_CS = 1 * MiB + 512 * 1024;
constexpr size_t WS_ECH = 2 * MiB;
constexpr size_t WS_DAS = 2 * MiB + 256 * 1024;
constexpr size_t WS_DAP = 2 * MiB + 512 * 1024;
constexpr size_t WS_WQK = 4 * MiB;
constexpr size_t WS_WUV = 6 * MiB;
constexpr size_t WS_WO = 10 * MiB;
constexpr size_t WS_WGU = 12 * MiB;
constexpr size_t WS_WD = 24 * MiB;
constexpr size_t WS_H = 32 * MiB;
constexpr size_t WS_Q = 192 * MiB;
constexpr size_t WS_K = 272 * MiB;
constexpr size_t WS_VTP = 352 * MiB;
constexpr size_t WS_VTS = 368 * MiB;
constexpr size_t WS_UTP = 432 * MiB;
constexpr size_t WS_UTS = 464 * MiB;
constexpr size_t WS_YP = 592 * MiB;
constexpr size_t WS_YS = 624 * MiB;
constexpr size_t WS_HID = 192 * MiB;
constexpr size_t WS_DBS = 752 * MiB;
constexpr size_t WS_DBP = 760 * MiB;
constexpr size_t WS_XB = 640 * MiB;
constexpr size_t WS_CAT = 832 * MiB;
constexpr size_t WS_END = 992 * MiB;
constexpr int LDS_BYTES = 151552;
#ifndef AT_SPLIT
#define AT_SPLIT 3
#endif

struct Args {
    const float *xp, *xs, *cp, *cs, *w_ada, *b_ada, *g_attn, *w_in, *g_q, *g_k, *w_fmix, *rpb, *g_fout, *g_aout, *w_o, *g_ffn, *w_gate, *w_up, *w_down;
    float* out; unsigned char* ws; int ph_lo, ph_hi;
};

__device__ __forceinline__ float wave_sum(float v) {
#pragma unroll
    for (int o = 1; o < 64; o <<= 1) v += __shfl_xor(v, o);
    return v;
}
__device__ __forceinline__ int batch_of(int tok) { return tok < NTOK_P ? (tok >> 12) : 4 + ((tok - NTOK_P) >> 13); }
__device__ __forceinline__ float bf_lo(unsigned w) { return __uint_as_float(w << 16); }
__device__ __forceinline__ float bf_hi(unsigned w) { return __uint_as_float(w & 0xffff0000u); }

struct DownOrder : public pg8::StaticOrder {
    static constexpr bool CUSTOMA = true;
    static constexpr size_t PS = (size_t)NTOK * 64;
    __device__ __forceinline__ unsigned a_voff(int R, int C) const { return (unsigned)((size_t)(C >> 5) * PS + (size_t)R * 64 + (size_t)(C & 31) * 2); }
    __device__ __forceinline__ size_t a_hstep() const { return (size_t)128 * 64; }
    __device__ __forceinline__ size_t a_kstep() const { return 2 * PS; }
    __device__ __forceinline__ size_t a_off(int pm) const { return (size_t)pm * 256 * 64; }
};
struct RowOrder {
    static constexpr bool CUSTOMB = false, CUSTOMA = false;
    int G, c, nN, pshift, pmask;
    __device__ bool next(int i, Unit& u) const { const long L = (long)i * G + c; if (L >= nN) return false; u.pm = ((int)L >> pshift) & pmask; u.pn = (int)L; return true; }
    __device__ __forceinline__ void a_ready(const Unit&) const {}
    __device__ __forceinline__ void done(const Unit&) const {}
};
template <int T1> struct UOrder {
    static constexpr bool CUSTOMB = true, CUSTOMA = false;
    int G, c, nN, tokbase;
    __device__ bool next(int i, Unit& u) const { const long L = (long)i * G + c; if (L >= 4L * nN) return false; u.pm = (int)(L & 3); u.pn = (int)(L >> 2); return true; }
    __device__ __forceinline__ void a_ready(const Unit&) const {}
    __device__ __forceinline__ void done(const Unit&) const {}
    __device__ __forceinline__ unsigned b_voff(int Rb, int C, int K) const { const int tokoff = (T1 == 128) ? Rb * 64 : ((Rb & 63) * 64 + (Rb >> 6)); return (unsigned)(tokoff * K + C) * 2u; }
    __device__ __forceinline__ size_t b_hstep(int K) const { return (size_t)((T1 == 128) ? 1 : 2) * K * 2; }
    __device__ __forceinline__ size_t b_off(int pn, int K) const {
        const int n0 = pn * 256; int tok;
        if (T1 == 128) tok = tokbase + (n0 >> 13) * 8192 + ((n0 & 8191) >> 7); else tok = tokbase + (n0 >> 12) * 4096 + ((n0 & 4095) >> 6);
        return (size_t)tok * K * 2;
    }
};

struct EpiQK {
    static constexpr bool MIDK = false; static constexpr bool PERM = true, AFTER_DRAIN = false;
    bf16* Q; bf16* K; const float* gq; const float* gk;
    __device__ __forceinline__ void operator()(const f32x4 (&acc)[2][2][4][2], const Unit& u, int wr, int wc, int fr, int fq) const {
        const bool isq = u.pn < 2; bf16* base = isq ? Q : K; const float* g = isq ? gq : gk; const float sc = isq ? 0.125f * 1.4426950408889634f : 1.0f;
        const int head = 4 * (u.pn & 1) + wc;
        f32x4 gv[2][2];
#pragma unroll
        for (int bj = 0; bj < 2; ++bj)
#pragma unroll
            for (int n = 0; n < 2; ++n) gv[bj][n] = *(const f32x4*)(g + 32 * bj + 8 * fq + 4 * n) * sc;
#pragma unroll
        for (int ai = 0; ai < 2; ++ai)
#pragma unroll
            for (int m = 0; m < 4; ++m) {
                float ss = 0.f;
#pragma unroll
                for (int bj = 0; bj < 2; ++bj)
#pragma unroll
                    for (int n = 0; n < 2; ++n) { const f32x4 v = acc[ai][bj][m][n]; ss += (v[0] * v[0] + v[1] * v[1]) + (v[2] * v[2] + v[3] * v[3]); }
                ss += __shfl_xor(ss, 16); ss += __shfl_xor(ss, 32);
                const float rstd = rsqrtf(ss * (1.0f / 64.0f) + EPS);
                const int row = u.pm * 256 + ai * 128 + wr * 64 + m * 16 + fr;
                bf16* p = base + (size_t)row * 512 + head * 64 + 8 * fq;
#pragma unroll
                for (int bj = 0; bj < 2; ++bj) {
                    const f32x4 v0 = acc[ai][bj][m][0] * gv[bj][0] * rstd, v1 = acc[ai][bj][m][1] * gv[bj][1] * rstd;
                    v4u w; w.x = cvt_pk_bf16(v0[0], v0[1]); w.y = cvt_pk_bf16(v0[2], v0[3]); w.z = cvt_pk_bf16(v1[0], v1[1]); w.w = cvt_pk_bf16(v1[2], v1[3]);
                    *(v4u*)(p + 32 * bj) = w;
                }
            }
    }
};
template <int T1> struct EpiU {
    static constexpr bool MIDK = false; static constexpr bool PERM = true, AFTER_DRAIN = false;
    bf16* UT;
    __device__ __forceinline__ void operator()(const f32x4 (&acc)[2][2][4][2], const Unit& u, int wr, int wc, int fr, int fq) const {
#pragma unroll
        for (int ai = 0; ai < 2; ++ai)
#pragma unroll
            for (int m = 0; m < 4; ++m) {
                const int cp = u.pm * 256 + ai * 128 + wr * 64 + m * 16 + fr, cs = cp >> 9, ch = cp & 511;
#pragma unroll
                for (int bj = 0; bj < 2; ++bj) {
                    const int nb = u.pn * 256 + bj * 128 + wc * 32 + 8 * fq;
                    size_t addr;
                    if (T1 == 128) { const int sq = nb >> 13, nl = nb & 8191, t2 = nl >> 7, t1 = nl & 127; addr = ((size_t)((sq * 512 + ch) * 64 + t2)) * 256 + cs * 128 + t1; }
                    else { const int sq = nb >> 12, nl = nb & 4095, t2 = nl >> 6, t1 = nl & 63; addr = ((size_t)((sq * 512 + ch) * 64 + t2)) * 128 + cs * 64 + t1; }
                    const f32x4 v0 = acc[ai][bj][m][0], v1 = acc[ai][bj][m][1];
                    v4u w; w.x = cvt_pk_bf16(v0[0], v0[1]); w.y = cvt_pk_bf16(v0[2], v0[3]); w.z = cvt_pk_bf16(v1[0], v1[1]); w.w = cvt_pk_bf16(v1[2], v1[3]);
                    *(v4u*)(UT + addr) = w;
                }
            }
    }
};
struct EpiV {
    static constexpr bool MIDK = false; static constexpr bool PERM = true, AFTER_DRAIN = false;
    unsigned char* ws;
    __device__ __forceinline__ void operator()(const f32x4 (&acc)[2][2][4][2], const Unit& u, int wr, int wc, int fr, int fq) const {
        const int tokt = u.pn * 256; const bool isP = tokt < NTOK_P;
        int b, t0, T;
        if (isP) { b = tokt >> 12; t0 = tokt & 4095; T = TP; } else { const int tt = tokt - NTOK_P; b = tt >> 13; t0 = tt & 8191; T = TS; }
        bf16* dst = (bf16*)(ws + (isP ? WS_VTP : WS_VTS));
        const int rowbase = b * 512 + u.pm * 256;
#pragma unroll
        for (int ai = 0; ai < 2; ++ai)
#pragma unroll
            for (int m = 0; m < 4; ++m) {
                const int r = rowbase + ai * 128 + wr * 64 + m * 16 + fr;
                bf16* p = dst + (size_t)r * T + t0 + wc * 32 + 8 * fq;
#pragma unroll
                for (int bj = 0; bj < 2; ++bj) {
                    const f32x4 v0 = acc[ai][bj][m][0], v1 = acc[ai][bj][m][1];
                    v4u w; w.x = cvt_pk_bf16(v0[0], v0[1]); w.y = cvt_pk_bf16(v0[2], v0[3]); w.z = cvt_pk_bf16(v1[0], v1[1]); w.w = cvt_pk_bf16(v1[2], v1[3]);
                    *(v4u*)(p + 128 * bj) = w;
                }
            }
    }
};
template <int T1> struct EpiA {
    static constexpr bool MIDK = false; static constexpr bool PERM = true, AFTER_DRAIN = false;
    bf16* Y;
    __device__ __forceinline__ void operator()(const f32x4 (&acc)[2][2][4][2], const Unit& u, int wr, int wc, int fr, int fq) const {
        if (T1 == 64 && wr != 0) return;
#pragma unroll
        for (int m = 0; m < 4; ++m) {
            const int k1 = (T1 == 128 ? 64 * wr : 0) + 16 * m + fr;
#pragma unroll
            for (int bj = 0; bj < 2; ++bj) {
                const int nb = u.pn * 256 + bj * 128 + wc * 32 + 8 * fq, sq = nb >> 15, ch = (nb >> 6) & 511, t2b = nb & 63;
                bf16* p = Y + ((size_t)((sq * T1 + k1) * 512 + ch)) * 128 + t2b;
#pragma unroll
                for (int ri = 0; ri < 2; ++ri) {
                    const f32x4 v0 = acc[ri][bj][m][0], v1 = acc[ri][bj][m][1];
                    v4u w; w.x = cvt_pk_bf16(v0[0], v0[1]); w.y = cvt_pk_bf16(v0[2], v0[3]); w.z = cvt_pk_bf16(v1[0], v1[1]); w.w = cvt_pk_bf16(v1[2], v1[3]);
                    *(v4u*)(p + 64 * ri) = w;
                }
            }
        }
    }
};
template <int T1> struct EpiB {
    static constexpr bool MIDK = false; static constexpr bool PERM = true, AFTER_DRAIN = false;
    bf16* CAT; float* ssqf; int tokbase;
    __device__ __forceinline__ void operator()(const f32x4 (&acc)[2][2][4][2], const Unit& u, int wr, int wc, int fr, int fq) const {
        if (wr != 0) return;
        const int sk1 = u.pn >> 1, sq = sk1 / T1, k1 = sk1 % T1;
#pragma unroll
        for (int m = 0; m < 4; ++m) {
            const int k2 = 16 * m + fr, tok = tokbase + sq * (64 * T1) + k1 + T1 * k2;
            float ss = 0.f;
#pragma unroll
            for (int bj = 0; bj < 2; ++bj) {
                const int ch = (u.pn & 1) * 256 + bj * 128 + wc * 32 + 8 * fq;
                const f32x4 v0 = acc[0][bj][m][0], v1 = acc[0][bj][m][1];
                ss += (v0[0] * v0[0] + v0[1] * v0[1]) + (v0[2] * v0[2] + v0[3] * v0[3]) + (v1[0] * v1[0] + v1[1] * v1[1]) + (v1[2] * v1[2] + v1[3] * v1[3]);
                v4u w; w.x = cvt_pk_bf16(v0[0], v0[1]); w.y = cvt_pk_bf16(v0[2], v0[3]); w.z = cvt_pk_bf16(v1[0], v1[1]); w.w = cvt_pk_bf16(v1[2], v1[3]);
                *(v4u*)(CAT + (size_t)tok * 1024 + ch) = w;
            }
            ss += __shfl_xor(ss, 16); ss += __shfl_xor(ss, 32);
            if (fq == 0) unsafeAtomicAdd(ssqf + tok, ss);
        }
    }
};
struct EpiWo {
    static constexpr bool MIDK = true; static constexpr int MIDT = 8;
    static constexpr bool PERM = true, AFTER_DRAIN = false;
    const float* xp; const float* xs; bf16* XB; const float* mod; float* ssq; const LAS float* rs;
    __device__ __forceinline__ void mid(f32x4 (&acc)[2][2][4][2], int ui, int wr, int wc, int fr, int fq) const {
#pragma unroll
        for (int ai = 0; ai < 2; ++ai)
#pragma unroll
            for (int m = 0; m < 4; ++m) {
                const float ratio = rs[ui * 512 + 2 * (ai * 128 + wr * 64 + m * 16 + fr)];
#pragma unroll
                for (int bj = 0; bj < 2; ++bj)
#pragma unroll
                    for (int n = 0; n < 2; ++n) acc[ai][bj][m][n] *= ratio;
            }
    }
    __device__ __forceinline__ void fin(const f32x4 (&acc)[2][2][4][2], const Unit& u, int ui, int wr, int wc, int fr, int fq) const {
        const int tokt = u.pm * 256, b = batch_of(tokt);
        const float* xb = tokt < NTOK_P ? xp + (size_t)tokt * D : xs + (size_t)(tokt - NTOK_P) * D;
        const int col0 = u.pn * 256 + wc * 32 + 8 * fq;
        const float* gp = mod + b * NMOD + 2048 + col0;
        bf16* xbo = XB + (size_t)tokt * D;
        f32x4 gt[2][2];
#pragma unroll
        for (int bj = 0; bj < 2; ++bj)
#pragma unroll
            for (int n = 0; n < 2; ++n) gt[bj][n] = *(const f32x4*)(gp + bj * 128 + 4 * n);
#pragma unroll
        for (int ai = 0; ai < 2; ++ai)
#pragma unroll
            for (int mp = 0; mp < 2; ++mp) {
                f32x4 xv[2][2][2];
#pragma unroll
                for (int mm = 0; mm < 2; ++mm)
#pragma unroll
                    for (int bj = 0; bj < 2; ++bj)
#pragma unroll
                        for (int n = 0; n < 2; ++n) xv[mm][bj][n] = *(const f32x4*)(xb + (unsigned)((ai * 128 + wr * 64 + (2 * mp + mm) * 16 + fr) * D + col0 + bj * 128 + 4 * n));
                asm volatile("" ::: "memory");
#pragma unroll
                for (int mm = 0; mm < 2; ++mm) {
                    const int m = 2 * mp + mm, rl = ai * 128 + wr * 64 + m * 16 + fr; float ss = 0.f;
                    const float ra = rs[ui * 512 + 2 * rl + 1];
#pragma unroll
                    for (int bj = 0; bj < 2; ++bj) {
                        const unsigned off = (unsigned)(rl * D + col0 + bj * 128);
                        const f32x4 o0 = xv[mm][bj][0] + gt[bj][0] * (acc[ai][bj][m][0] * ra), o1 = xv[mm][bj][1] + gt[bj][1] * (acc[ai][bj][m][1] * ra);
                        ss += (o0[0] * o0[0] + o0[1] * o0[1]) + (o0[2] * o0[2] + o0[3] * o0[3]) + (o1[0] * o1[0] + o1[1] * o1[1]) + (o1[2] * o1[2] + o1[3] * o1[3]);
                        v4u w; w.x = cvt_pk_bf16(o0[0], o0[1]); w.y = cvt_pk_bf16(o0[2], o0[3]); w.z = cvt_pk_bf16(o1[0], o1[1]); w.w = cvt_pk_bf16(o1[2], o1[3]);
                        *(v4u*)(xbo + off) = w;
                    }
                    ss += __shfl_xor(ss, 16); ss += __shfl_xor(ss, 32);
                    if (fq == 0) unsafeAtomicAdd(ssq + tokt + rl, ss);
                }
            }
    }
};
struct EpiUp {
    static constexpr bool MIDK = false; static constexpr bool PERM = true, AFTER_DRAIN = false;
    bf16* HID;
    __device__ __forceinline__ void operator()(const f32x4 (&acc)[2][2][4][2], const Unit& u, int wr, int wc, int fr, int fq) const {
#pragma unroll
        for (int ai = 0; ai < 2; ++ai)
#pragma unroll
            for (int m = 0; m < 4; ++m) {
                const int row = u.pm * 256 + ai * 128 + wr * 64 + m * 16 + fr;
                bf16* p = HID + (size_t)(4 * u.pn + wc) * ((size_t)NTOK * 32) + (size_t)row * 32 + 8 * fq;
                float v[8];
#pragma unroll
                for (int n = 0; n < 2; ++n)
#pragma unroll
                    for (int i = 0; i < 4; ++i) { const float g = acc[ai][0][m][n][i], up = acc[ai][1][m][n][i]; v[4 * n + i] = g * __builtin_amdgcn_rcpf(1.0f + __expf(-g)) * up; }
                v4u w; w.x = cvt_pk_bf16(v[0], v[1]); w.y = cvt_pk_bf16(v[2], v[3]); w.z = cvt_pk_bf16(v[4], v[5]); w.w = cvt_pk_bf16(v[6], v[7]);
                *(v4u*)p = w;
            }
    }
};
struct EpiDown {
    static constexpr bool MIDK = false; struct Carry {}; static constexpr bool PERM = false, AFTER_DRAIN = false;
    float* out; const bf16* XB; const float* mod; LAS float* tws;
    __device__ __forceinline__ void operator()(const f32x4 (&acc)[2][2][4][2], const Unit& u, int wr, int wc, int fr, int fq) const {
        const int tokt = u.pm * 256, b = batch_of(tokt);
        const int col0 = u.pn * 256 + wc * 32 + 4 * fq;
        f32x4 gt[2][2];
#pragma unroll
        for (int bj = 0; bj < 2; ++bj)
#pragma unroll
            for (int n = 0; n < 2; ++n) gt[bj][n] = *(const f32x4*)(mod + b * NMOD + 5120 + col0 + bj * 128 + n * 16);
        LAS float* tw = tws + (wr * 4 + wc) * 576;
        const int lane = fq * 16 + fr, rr = lane >> 3, ch = lane & 7;
        const bf16* xbo = XB + (size_t)tokt * D + u.pn * 256 + wc * 32 + 4 * ch; float* oo = out + (size_t)tokt * D + u.pn * 256 + wc * 32 + 4 * ch;
        unsigned off = (unsigned)((wr * 64 + rr) * D);
        v2u xa = *(const v2u*)(xbo + off), xc = *(const v2u*)(xbo + off + 8 * D);
#pragma unroll
        for (int it = 0; it < 16; ++it) {
            const int ai = it >> 3, m = (it >> 1) & 3, bj = it & 1;
            const int delta = (bj == 0) ? 128 : ((m < 3) ? 16 * D - 128 : (128 - 48) * D - 128);
            unsigned nxt = off + (unsigned)delta; asm volatile("" : "+v"(nxt));
            v2u na = xa, nc = xc;
            if (it < 15) { na = *(const v2u*)(xbo + nxt); nc = *(const v2u*)(xbo + nxt + 8 * D); }
#pragma unroll
            for (int n = 0; n < 2; ++n) *(LAS f32x4*)(tw + fr * 36 + 16 * n + 4 * fq) = gt[bj][n] * acc[ai][bj][m][n];
            const f32x4 va = *(const LAS f32x4*)(tw + rr * 36 + 4 * ch), vc = *(const LAS f32x4*)(tw + (rr + 8) * 36 + 4 * ch);
            *(f32x4*)(oo + off) = (f32x4){bf_lo(xa.x), bf_hi(xa.x), bf_lo(xa.y), bf_hi(xa.y)} + va;
            *(f32x4*)(oo + off + 8 * D) = (f32x4){bf_lo(xc.x), bf_hi(xc.x), bf_lo(xc.y), bf_hi(xc.y)} + vc;
            xa = na; xc = nc; off = nxt;
            asm volatile("" ::: "memory");
        }
    }
};

__device__ __forceinline__ int rowmap(int kind, int n) {
    switch (kind) {
        case 1: return (n & ~255) + 128 * ((n >> 5) & 1) + 32 * ((n >> 6) & 3) + (n & 31);
        case 2: return 256 * (n >> 7) + (n & 127);
        case 3: return 256 * (n >> 7) + 128 + (n & 127);
        case 4: return 1024 + n;
        default: return n;
    }
}
__device__ __forceinline__ void tr_item(const float* W, int ldw, int col0, int K, bf16* WT, int kind, int nblk, LAS float* scr, int item, int lane, const float* ks0 = nullptr, const float* ks1 = nullptr) {
    const int kb = item / nblk, nb = item % nblk, k0 = 64 * kb, n0 = 32 * nb;
    const float* ks = ks0 ? (k0 < 512 ? ks0 + k0 : ks1 + (k0 - 512)) : nullptr;
#pragma unroll 8
    for (int i = 0; i < 32; ++i) { const int kk = 2 * i + (lane >> 5); scr[kk * 33 + (lane & 31)] = W[(size_t)(k0 + kk) * ldw + col0 + n0 + (lane & 31)] * (ks ? ks[kk] : 1.0f); }
    asm volatile("s_waitcnt lgkmcnt(0)" ::: "memory");
    const int c = lane & 7;
#pragma unroll
    for (int j = 0; j < 4; ++j) {
        const int n = (lane >> 3) + 8 * j; const LAS float* s = scr + (8 * c) * 33 + n;
        v4u o; o.x = cvt_pk_bf16(s[0 * 33], s[1 * 33]); o.y = cvt_pk_bf16(s[2 * 33], s[3 * 33]); o.z = cvt_pk_bf16(s[4 * 33], s[5 * 33]); o.w = cvt_pk_bf16(s[6 * 33], s[7 * 33]);
        *(v4u*)(WT + (size_t)rowmap(kind, n0 + n) * K + k0 + 8 * c) = o;
    }
    asm volatile("s_waitcnt lgkmcnt(0)" ::: "memory");
}

__device__ __forceinline__ void phase0(const Args& a, LAS unsigned char* lds, int tid, int lane, int wave, int bid, int G) {
    unsigned char* ws = a.ws;
    float* mod = (float*)(ws + WS_MOD);
    for (int task = bid; task < NMOD / 64; task += G) {
        LAS float* sc = (LAS float*)lds;
        LAS float* red = (LAS float*)(lds + 49152);
        for (int u = tid; u < 12 * 1024; u += 512) { const int b = u >> 10, i = u & 1023; const float c = b < 4 ? a.cp[b * 1024 + i] : a.cs[(b - 4) * 1024 + i]; sc[u] = c / (1.0f + __expf(-c)); }
        __syncthreads();
        const int j0 = task * 64;
        float acc[12];
#pragma unroll
        for (int b = 0; b < 12; ++b) acc[b] = 0.f;
        for (int ii = 0; ii < 128; ++ii) {
            const int i = wave * 128 + ii; const float w = a.w_ada[(size_t)i * NMOD + j0 + lane];
#pragma unroll
            for (int b = 0; b < 12; ++b) acc[b] += sc[b * 1024 + i] * w;
        }
#pragma unroll
        for (int b = 0; b < 12; ++b) red[(wave * 12 + b) * 64 + lane] = acc[b];
        __syncthreads();
        for (int u = tid; u < 768; u += 512) {
            const int b = u >> 6, col = u & 63; float s = a.b_ada[j0 + col];
#pragma unroll
            for (int w = 0; w < 8; ++w) s += red[(w * 12 + b) * 64 + col];
            mod[b * NMOD + j0 + col] = s;
        }
        __syncthreads();
    }
    {
        LAS float* scr = (LAS float*)(lds + wave * 16384);
        const int gw = bid * 8 + wave, NGW = G * 8;
        constexpr int I_QK = 16 * 32, I_V = 16 * 16, I_O = 16 * 32, I_G = 16 * 88, I_D = 44 * 32;
        constexpr int NITEMS = I_QK + I_V + I_O + 2 * I_G + I_D;
        for (int it = gw; it < NITEMS; it += NGW) {
            int r = it;
            if (r < I_QK) { tr_item(a.w_in, 2048, 512, 1024, (bf16*)(ws + WS_WQK), 1, 32, scr, r, lane); continue; } r -= I_QK;
            if (r < I_V) { tr_item(a.w_in, 2048, 1536, 1024, (bf16*)(ws + WS_WUV), 4, 16, scr, r, lane); continue; } r -= I_V;
            if (r < I_O) { tr_item(a.w_o, 1024, 0, 1024, (bf16*)(ws + WS_WO), 0, 32, scr, r, lane, a.g_fout, a.g_aout); continue; } r -= I_O;
            if (r < I_G) { tr_item(a.w_gate, DFF, 0, 1024, (bf16*)(ws + WS_WGU), 2, 88, scr, r, lane); continue; } r -= I_G;
            if (r < I_G) { tr_item(a.w_up, DFF, 0, 1024, (bf16*)(ws + WS_WGU), 3, 88, scr, r, lane); continue; } r -= I_G;
            tr_item(a.w_down, 1024, 0, DFF, (bf16*)(ws + WS_WD), 0, 32, scr, r, lane);
        }
    }
    {
        float* CS = (float*)(ws + WS_CS);
        for (int o = bid * 512 + tid; o < 2 * 4 * 128 * 128; o += G * 512) {
            const int d = o & 127, c = (o >> 7) & 127, g = (o >> 14) & 3, cs = o >> 16;
            float s = 0.f;
            for (int e = 0; e < 128; ++e) {
                const float ang = (float)((c * e) & 127) * (1.0f / 128.0f);
                const float t = cs ? __builtin_amdgcn_sinf(ang) : __builtin_amdgcn_cosf(ang);
                s += t * a.w_fmix[(g * 128 + e) * 128 + d];
            }
            CS[o] = s * 0.08838834764831845f;
        }
    }
    {
        bf16* DAS = (bf16*)(ws + WS_DAS); bf16* DAP = (bf16*)(ws + WS_DAP);
        for (int o = bid * 512 + tid; o < 65536 + 32768; o += G * 512) {
            float v = 0.f; bf16* dst;
            if (o < 65536) {
                const int r = o >> 8, k = o & 255, ri = r >> 7, k1 = r & 127, cs = k >> 7, t1 = k & 127;
                const float f = (float)((k1 * t1) & 127) * (1.0f / 128.0f), c = __builtin_amdgcn_cosf(f), sn = __builtin_amdgcn_sinf(f);
                v = (ri == 0 ? (cs == 0 ? c : -sn) : (cs == 0 ? -sn : -c)) * 0.08838834764831845f; dst = DAS + o;
            } else {
                const int o2 = o - 65536, r = o2 >> 7, k = o2 & 127, ri = r >> 7, rr = r & 127, cs = k >> 6, t1 = k & 63;
                if (rr < 64) { const float f = (float)((rr * t1) & 63) * (1.0f / 64.0f), c = __builtin_amdgcn_cosf(f), sn = __builtin_amdgcn_sinf(f);
                    v = (ri == 0 ? (cs == 0 ? c : -sn) : (cs == 0 ? -sn : -c)) * 0.125f; }
                dst = DAP + o2;
            }
            *dst = (bf16)(cvt_pk_bf16(v, 0.f) & 0xffffu);
        }
        for (int it = bid * 512 + tid; it < (128 + 64) * 256 * 16; it += G * 512) {
            const bool isS = it < 128 * 256 * 16; const int i2 = isS ? it : it - 128 * 256 * 16;
            const int row = i2 >> 4, k0 = (i2 & 15) * 8, k1 = row >> 8, r = row & 255, ri = k0 >> 6, t2 = k0 & 63;
            const int T1 = isS ? 128 : 64, T = 64 * T1, kk = k1 + T1 * r;
            float v[8];
#pragma unroll
            for (int e = 0; e < 8; ++e) { const float f = (float)((kk * (t2 + e)) & (T - 1)) * (1.0f / (float)T); v[e] = r < 64 ? (ri == 0 ? __builtin_amdgcn_cosf(f) : __builtin_amdgcn_sinf(f)) * 0.125f : 0.f; }
            v4u w; w.x = cvt_pk_bf16(v[0], v[1]); w.y = cvt_pk_bf16(v[2], v[3]); w.z = cvt_pk_bf16(v[4], v[5]); w.w = cvt_pk_bf16(v[6], v[7]);
            *(v4u*)((bf16*)(ws + (isS ? WS_DBS : WS_DBP)) + (size_t)row * 128 + k0) = w;
        }
    }
}

template <bool FROM_SSQ>
__device__ __forceinline__ void norm_rows(const Args& a, const float* xsrc_p, const float* xsrc_s, const float* g, int shift_off, int scale_off, const float* ssq, bf16* H, int lane, int gw, int NGW) {
    const float* mod = (const float*)(a.ws + WS_MOD);
    for (int ch = gw; ch < NTOK / 8; ch += NGW) {
        const int tok0 = ch * 8, b = batch_of(tok0);
        const float* mb = mod + b * NMOD;
        f32x4 gs[4], sh[4];
#pragma unroll
        for (int jj = 0; jj < 4; ++jj) {
            const int c = lane * 4 + 256 * jj;
            gs[jj] = *(const f32x4*)(g + c) * (*(const f32x4*)(mb + scale_off + c) + 1.0f);
            sh[jj] = *(const f32x4*)(mb + shift_off + c);
        }
        for (int tt = 0; tt < 8; ++tt) {
            const int tok = tok0 + tt;
            const float* xr = tok < NTOK_P ? xsrc_p + (size_t)tok * D : xsrc_s + (size_t)(tok - NTOK_P) * D;
            f32x4 v[4]; float ss = 0.f;
#pragma unroll
            for (int jj = 0; jj < 4; ++jj) { if (FROM_SSQ) { const v2u xw = *(const v2u*)((const bf16*)xsrc_p + (size_t)tok * D + lane * 4 + 256 * jj); v[jj] = (f32x4){bf_lo(xw.x), bf_hi(xw.x), bf_lo(xw.y), bf_hi(xw.y)}; } else v[jj] = *(const f32x4*)(xr + lane * 4 + 256 * jj); ss += (v[jj][0] * v[jj][0] + v[jj][1] * v[jj][1]) + (v[jj][2] * v[jj][2] + v[jj][3] * v[jj][3]); }
            float tot;
            if (FROM_SSQ) tot = ssq[tok]; else tot = wave_sum(ss);
            const float rstd = rsqrtf(tot * (1.0f / 1024.0f) + EPS);
#pragma unroll
            for (int jj = 0; jj < 4; ++jj) {
                const f32x4 o = v[jj] * rstd * gs[jj] + sh[jj];
                v2u w; w.x = cvt_pk_bf16(o[0], o[1]); w.y = cvt_pk_bf16(o[2], o[3]);
                *(v2u*)(H + (size_t)tok * D + lane * 4 + 256 * jj) = w;
            }
        }
    }
}

__device__ __forceinline__ void fold_uw(const Args& a, LAS unsigned char* lds, int tid, int bid, int G) {
    const float* CS = (const float*)(a.ws + WS_CS);
    bf16* WUV = (bf16*)(a.ws + WS_WUV);
    LAS float* Wt = (LAS float*)lds;
    LAS float* CSl = (LAS float*)(lds + 16384);
    for (int task = bid; task < 256; task += G) {
        const int cs = task >> 7, g = (task >> 5) & 3, i0 = (task & 31) * 32;
        for (int u = tid; u < 32 * 128; u += 512) { const int i = u >> 7, c = u & 127; Wt[u] = a.w_in[(size_t)(i0 + i) * 2048 + g * 128 + c]; }
        for (int u = tid; u < 128 * 128; u += 512) CSl[u] = CS[(size_t)(cs * 4 + g) * 16384 + u];
        __syncthreads();
        const int d = tid & 127, iq = tid >> 7;
        float acc[8];
#pragma unroll
        for (int ii = 0; ii < 8; ++ii) acc[ii] = 0.f;
        for (int c = 0; c < 128; ++c) {
            const float csv = CSl[c * 128 + d];
#pragma unroll
            for (int ii = 0; ii < 8; ++ii) acc[ii] += Wt[(iq * 8 + ii) * 128 + c] * csv;
        }
        v4u w; w.x = cvt_pk_bf16(acc[0], acc[1]); w.y = cvt_pk_bf16(acc[2], acc[3]); w.z = cvt_pk_bf16(acc[4], acc[5]); w.w = cvt_pk_bf16(acc[6], acc[7]);
        *(v4u*)(WUV + (size_t)(cs * 512 + g * 128 + d) * 1024 + i0 + iq * 8) = w;
        __syncthreads();
    }
}

constexpr int AT_ROWB = 144, AT_SLOT = 2 * 64 * AT_ROWB;
constexpr int AT_RPB_OFF = 40960, AT_SMAX_OFF = AT_RPB_OFF + 8 * 480 * 4;
__device__ __forceinline__ void attn_task(const Args& a, int task, LAS unsigned char* lds, int tid, int wave, int lane, const unsigned (&idxp)[4], const int mbits) {
    const bf16* Q = (const bf16*)(a.ws + WS_Q); const bf16* K = (const bf16*)(a.ws + WS_K); bf16* CAT = (bf16*)(a.ws + WS_CAT);
    float* ssqa = (float*)(a.ws + WS_SSQA);
    int h, i0, T, tok0, rows; const bf16* vt;
    if (task < 256) { const int seq = task >> 6; h = (task >> 3) & 7; i0 = (task & 7) * 8; T = TP; tok0 = seq * TP; rows = 64; vt = (const bf16*)(a.ws + WS_VTP) + (size_t)seq * 512 * TP; }
    else { const int t2 = task - 256, seq = t2 >> 7; h = (t2 >> 4) & 7; i0 = (t2 & 15) * 8; T = TS; tok0 = NTOK_P + seq * TS; rows = 128; vt = (const bf16*)(a.ws + WS_VTS) + (size_t)seq * 512 * TS; }
    const int q = lane & 15, g = lane >> 4, i = i0 + wave;
    const int rsw = min(max(i - 4, 0), rows - 8);
    const int kr_lo = min(max(i0 - 4, 0), rows - 8), kr_hi = min(max(i0 + 3, 0), rows - 8) + 7;
    const LAS unsigned char* tabh = lds + AT_RPB_OFF + h * 1920;
    const bf16* kg = K + (size_t)(tok0 + (tid >> 3)) * 512 + 64 * h + (tid & 7) * 8;
    const bf16* vg = vt + (size_t)(64 * h + (tid >> 3)) * T + (tid & 7) * 8;
    const int stoff = (tid >> 3) * AT_ROWB + (tid & 7) * 16;
    v4u kst[2], vst[2];
#pragma unroll
    for (int u = 0; u < 2; ++u) if (kr_lo + u <= kr_hi) { kst[u] = *(const v4u*)(kg + (size_t)(kr_lo + u) * 64 * 512); vst[u] = *(const v4u*)(vg + (kr_lo + u) * 64); }
    bf16x8 bq[4][2];
#pragma unroll
    for (int j = 0; j < 4; ++j) { const bf16* qp = Q + (size_t)(tok0 + i * 64 + 16 * j + q) * 512 + 64 * h + 8 * g; bq[j][0] = *(const bf16x8*)qp; bq[j][1] = *(const bf16x8*)(qp + 32); }
    f32x4 O[4][4]; float sum[4];
#pragma unroll
    for (int j = 0; j < 4; ++j) { sum[j] = 0.f;
#pragma unroll
        for (int db = 0; db < 4; ++db) O[j][db] = (f32x4){0.f, 0.f, 0.f, 0.f}; }
    *(LAS v4u*)(lds + (kr_lo & 1) * AT_SLOT + stoff) = kst[0]; *(LAS v4u*)(lds + (kr_lo & 1) * AT_SLOT + 64 * AT_ROWB + stoff) = vst[0];
    __syncthreads();
    for (int base = kr_lo; base <= kr_hi; base += 2) {
#pragma unroll
      for (int u = 0; u < 2; ++u) {
        const int kr = base + u;
        if (kr > kr_hi) break;
        if (kr + 2 <= kr_hi) { kst[u] = *(const v4u*)(kg + (size_t)(kr + 2) * 64 * 512); vst[u] = *(const v4u*)(vg + (kr + 2) * 64); }
        if (kr >= rsw && kr < rsw + 8) {
            const LAS unsigned char* Ks = lds + (kr & 1) * AT_SLOT; const LAS unsigned char* Vs = Ks + 64 * AT_ROWB;
            const LAS unsigned char* rb = tabh + (kr - i + 7) * 128;
            bf16x8 kf[2][4]; float tbv[2][4];
#define AT_LOADK(j_, buf_) do { const int kc0_ = ((j_) == 0) ? 0 : ((j_) == 1) ? 8 : ((j_) == 2) ? 24 : 32; \
                _Pragma("unroll") for (int cb = 0; cb < 2; ++cb) { const LAS unsigned char* kp = Ks + (kc0_ + 16 * cb + q) * AT_ROWB + 16 * g; \
                    kf[buf_][2 * cb] = *(const LAS bf16x8*)kp; kf[buf_][2 * cb + 1] = *(const LAS bf16x8*)(kp + 64); } \
                _Pragma("unroll") for (int e = 0; e < 4; ++e) tbv[buf_][e] = *(const LAS float*)(rb + ((idxp[j_] >> (8 * e)) & 0xffu)); } while (0)
            AT_LOADK(0, 0);
#pragma unroll
            for (int j = 0; j < 4; ++j) {
                const int kc0 = (j == 0) ? 0 : (j == 1) ? 8 : (j == 2) ? 24 : 32;
                const int cur = j & 1;
                v2u vlo[4], vhi[4];
#pragma unroll
                for (int db = 0; db < 4; ++db) { const LAS unsigned char* vp = Vs + (16 * db + q) * AT_ROWB + (kc0 + 4 * g) * 2; vlo[db] = *(const LAS v2u*)vp; vhi[db] = *(const LAS v2u*)(vp + 32); }
                if (j < 3) AT_LOADK(j + 1, cur ^ 1);
                __builtin_amdgcn_sched_barrier(0);
                f32x4 sv[2];
                __builtin_amdgcn_s_setprio(1);
#pragma unroll
                for (int cb = 0; cb < 2; ++cb) {
                    f32x4 z = {0.f, 0.f, 0.f, 0.f};
                    z = __builtin_amdgcn_mfma_f32_16x16x32_bf16(kf[cur][2 * cb], bq[j][0], z, 0, 0, 0);
                    z = __builtin_amdgcn_mfma_f32_16x16x32_bf16(kf[cur][2 * cb + 1], bq[j][1], z, 0, 0, 0);
                    sv[cb] = z;
                }
                __builtin_amdgcn_s_setprio(0);
                float ps = 0.f;
#pragma unroll
                for (int e = 0; e < 4; ++e) {
                    const bool v0 = (mbits >> (j * 4 + e)) & 1;
                    const float p = __builtin_amdgcn_exp2f((v0 ? sv[0][e] : sv[1][e]) + tbv[cur][e]);
                    sv[0][e] = v0 ? p : 0.f; sv[1][e] = v0 ? 0.f : p; ps += p;
                }
                sum[j] += ps;
                v4u pw; pw.x = cvt_pk_bf16(sv[0][0], sv[0][1]); pw.y = cvt_pk_bf16(sv[0][2], sv[0][3]); pw.z = cvt_pk_bf16(sv[1][0], sv[1][1]); pw.w = cvt_pk_bf16(sv[1][2], sv[1][3]);
                const bf16x8 pf = __builtin_bit_cast(bf16x8, pw);
                __builtin_amdgcn_s_setprio(1);
#pragma unroll
                for (int db = 0; db < 4; ++db) {
                    v4u w; w.x = vlo[db].x; w.y = vlo[db].y; w.z = vhi[db].x; w.w = vhi[db].y;
                    O[j][db] = __builtin_amdgcn_mfma_f32_16x16x32_bf16(__builtin_bit_cast(bf16x8, w), pf, O[j][db], 0, 0, 0);
                }
                __builtin_amdgcn_s_setprio(0);
            }
#undef AT_LOADK
        }
        if (kr < kr_hi) { *(LAS v4u*)(lds + ((kr + 1) & 1) * AT_SLOT + stoff) = kst[(u + 1) & 1]; *(LAS v4u*)(lds + ((kr + 1) & 1) * AT_SLOT + 64 * AT_ROWB + stoff) = vst[(u + 1) & 1]; }
        __syncthreads();
      }
    }
#pragma unroll
    for (int j = 0; j < 4; ++j) {
        float sm = sum[j]; sm += __shfl_xor(sm, 16); sm += __shfl_xor(sm, 32);
        const float inv = 1.0f / sm; float ss = 0.f;
        const int tok = tok0 + i * 64 + 16 * j + q;
        bf16* op = CAT + (size_t)tok * 1024 + 512 + 64 * h + 4 * g;
#pragma unroll
        for (int db = 0; db < 4; ++db) {
            const f32x4 o = O[j][db] * inv;
            ss += (o[0] * o[0] + o[1] * o[1]) + (o[2] * o[2] + o[3] * o[3]);
            v2u w; w.x = cvt_pk_bf16(o[0], o[1]); w.y = cvt_pk_bf16(o[2], o[3]);
            *(v2u*)(op + 16 * db) = w;
        }
        ss += __shfl_xor(ss, 16); ss += __shfl_xor(ss, 32);
        if (g == 0) unsafeAtomicAdd(ssqa + tok, ss);
    }
}

__device__ __forceinline__ void attn_phase(const Args& a, LAS unsigned char* lds, int tid, int lane, int wave, int bid, int G, int part_lo, int part_hi) {
    {
        LAS float* tb = (LAS float*)(lds + AT_RPB_OFF) + wave * 480;
        float mb = 0.f;
        for (int idx = lane; idx < 465; idx += 64) mb = fmaxf(mb, fabsf(a.rpb[wave * 465 + idx]));
        float mq = fabsf(a.g_q[lane]), mk = fabsf(a.g_k[lane]);
#pragma unroll
        for (int o = 1; o < 64; o <<= 1) { mb = fmaxf(mb, __shfl_xor(mb, o)); mq = fmaxf(mq, __shfl_xor(mq, o)); mk = fmaxf(mk, __shfl_xor(mk, o)); }
        const float smax = 8.0f * mq * mk + mb;
        for (int idx = lane; idx < 480; idx += 64) { const int dr = idx >> 5, dc = idx & 31; tb[idx] = dc < 31 ? (a.rpb[wave * 465 + dr * 31 + dc] - smax) * 1.4426950408889634f : -1e30f; }
    }
    int mbits = 0;
    unsigned idxp[4];
    {
        const int q = lane & 15, g = lane >> 4;
#pragma unroll
        for (int j = 0; j < 4; ++j) {
            const int kc0 = (j == 0) ? 0 : (j == 1) ? 8 : (j == 2) ? 24 : 32;
            const int c = 16 * j + q, cst = min(max(c - 8, 0), 48);
            unsigned pk = 0u;
#pragma unroll
            for (int e = 0; e < 4; ++e) {
                const int k0c = kc0 + 4 * g + e, k1c = k0c + 16; const bool ok0 = (unsigned)(k0c - cst) < 16u;
                pk |= (unsigned)(((ok0 ? k0c : k1c) - c + 15) * 4) << (8 * e); mbits |= (ok0 ? 1 : 0) << (j * 4 + e);
            }
            idxp[j] = pk;
        }
    }
    __syncthreads();
    const int per = (1280 + G - 1) / G, r0 = bid * per, r1 = min(1280, r0 + per);
    for (int t = r0 + part_lo; t < min(r1, r0 + part_hi); ++t) attn_task(a, t, lds, tid, wave, lane, idxp, mbits);
    __syncthreads();
}

#define XB_TMO      128
#define XB_XCNT(j)  (256  + 64 * (j))
#define XB_XSUB(j)  (1280 + 64 * (j))
#define XB_XGEN(j)  (2304 + 64 * (j))
#define XB_TOP      3328
#define XB_TOPGEN   3392
#define XCD_BAR_WORDS 3456
#define XB_SPIN_CAP (1u << 18)

__device__ __forceinline__ unsigned xb_ld(unsigned* p)              { return __hip_atomic_load(p, __ATOMIC_RELAXED, __HIP_MEMORY_SCOPE_AGENT); }
__device__ __forceinline__ unsigned xb_add(unsigned* p, unsigned v) { return __hip_atomic_fetch_add(p, v, __ATOMIC_RELAXED, __HIP_MEMORY_SCOPE_AGENT); }
__device__ __forceinline__ unsigned xb_xcc_id() { return (unsigned)__builtin_amdgcn_s_getreg((3 << 11) | 20) & 0xFu; }
#define XB_SPIN(cond, bar) do { unsigned _sp = 0; while (cond) { __builtin_amdgcn_s_sleep(1); \
    if ((++_sp & 255u) == 0u) { if (xb_ld(&(bar)[XB_TMO])) break; if (_sp > XB_SPIN_CAP) { atomicAdd(&(bar)[XB_TMO], 1u); break; } } } } while (0)

struct XcdBarrier {
    unsigned* bar; unsigned x;
    volatile LAS unsigned* st;
};

__device__ __forceinline__ XcdBarrier xcd_barrier_post(unsigned* bar, volatile LAS unsigned* st) {
    XcdBarrier b; b.bar = bar; b.x = xb_xcc_id(); b.st = st;
    if (threadIdx.x == 0) (void)xb_add(&bar[XB_XCNT(b.x)], 1u);
    return b;
}
__device__ __forceinline__ void xcd_barrier_complete(unsigned* bar, unsigned x, unsigned& nloc, unsigned& nx) {
    const unsigned G = gridDim.x * gridDim.y * gridDim.z;
    unsigned sum, cnt, mine, sp = 0u;
    for (;;) {
        sum = 0u; cnt = 0u; mine = 0u;
#pragma unroll
        for (unsigned j = 0; j < 16; ++j) { const unsigned c = xb_ld(&bar[XB_XCNT(j)]); sum += c; cnt += (c > 0u) ? 1u : 0u; mine = (j == x) ? c : mine; }
        if (sum == G) break;
        __builtin_amdgcn_s_sleep(1);
        if ((++sp & 255u) == 0u) { if (xb_ld(&bar[XB_TMO])) break; if (sp > XB_SPIN_CAP) { atomicAdd(&bar[XB_TMO], 1u); break; } }
    }
    nloc = mine > 0u ? mine : 1u; nx = cnt > 0u ? cnt : 1u;
}

__device__ __forceinline__ void xcd_barrier(const XcdBarrier& b) {
    asm volatile("s_waitcnt vmcnt(0)" ::: "memory");
    __syncthreads();
    if (threadIdx.x == 0) {
        unsigned* bar = b.bar;
        __builtin_amdgcn_s_waitcnt(0);
        unsigned nloc = b.st[0], nx = b.st[1];
        if (nloc == 0u) { xcd_barrier_complete(bar, b.x, nloc, nx); b.st[0] = nloc; b.st[1] = nx; }
        const unsigned old = xb_add(&bar[XB_XSUB(b.x)], 1u);
        const unsigned gen = old / nloc;
        if (old + 1u == (gen + 1u) * nloc) {
            __builtin_amdgcn_fence(__ATOMIC_RELEASE, "agent");
            asm volatile("s_waitcnt vmcnt(0)" ::: "memory");
            const unsigned og = xb_add(&bar[XB_TOP], 1u);
            const unsigned tg = og / nx;
            if (og + 1u == (tg + 1u) * nx) xb_add(&bar[XB_TOPGEN], 1u);
            else XB_SPIN(xb_ld(&bar[XB_TOPGEN]) == tg, bar);
            __builtin_amdgcn_fence(__ATOMIC_ACQUIRE, "agent");
            xb_add(&bar[XB_XGEN(b.x)], 1u);
            asm volatile("s_waitcnt vmcnt(0)" ::: "memory");
        } else {
            XB_SPIN(xb_ld(&bar[XB_XGEN(b.x)]) == gen, bar);
            __builtin_amdgcn_fence(__ATOMIC_ACQUIRE, "agent");
            asm volatile("s_waitcnt vmcnt(0)" ::: "memory");
        }
    }
    __syncthreads();
}

__global__ void __launch_bounds__(512, 2) fwd_mega(Args a) {
    extern __shared__ __attribute__((aligned(16))) unsigned char lds_raw[];
    LAS unsigned char* lds = (LAS unsigned char*)lds_raw;
    cg::grid_group grid = cg::this_grid();
    const int tid = threadIdx.x, lane = tid & 63, wave = __builtin_amdgcn_readfirstlane(tid >> 6), bid = blockIdx.x, G = gridDim.x;
    const int gw = bid * 8 + wave, NGW = G * 8;
    unsigned char* ws = a.ws;
    const int lo = a.ph_lo, hi = a.ph_hi;
    volatile LAS unsigned* bst = (volatile LAS unsigned*)(lds + 131072 + 256);
    if (tid < 2) bst[tid] = 0u;
    __syncthreads();
    const XcdBarrier bar = xcd_barrier_post((unsigned*)(ws + WS_BAR), bst);
#define IN(k) (lo <= (k) && (k) < hi)
#define SEAM(k) do { if (IN(k) && IN((k) + 1)) xcd_barrier(bar); } while (0)
    if (hi < 0) grid.sync();

    if (IN(0)) phase0(a, lds, tid, lane, wave, bid, G);
    SEAM(0);
    if (IN(1)) {
        fold_uw(a, lds, tid, bid, G);
        norm_rows<false>(a, a.xp, a.xs, a.g_attn, 0, 1024, nullptr, (bf16*)(ws + WS_H), lane, gw, NGW);
    }
    SEAM(1);
    if (IN(2)) {
        { pg8::Gemm g{(const bf16*)(ws + WS_H), (const bf16*)(ws + WS_WQK), NTOK, 1024, 1024}; pg8::StaticOrder S; S.init(NTOK, 1024, G, bid);
          EpiQK E{(bf16*)(ws + WS_Q), (bf16*)(ws + WS_K), a.g_q, a.g_k};
          pg8::gemm_phase<EpiQK, pg8::StaticOrder, true, true>(lds, g, S, E); }
        { pg8::Gemm g{(const bf16*)(ws + WS_WUV), (const bf16*)(ws + WS_H), 1024, NTOK_S, 1024}; UOrder<128> S{G, bid, NTOK_S / 256, NTOK_P};
          EpiU<128> E{(bf16*)(ws + WS_UTS)};
          pg8::gemm_phase<EpiU<128>, UOrder<128>, true, true>(lds, g, S, E); }
        { pg8::Gemm g{(const bf16*)(ws + WS_WUV), (const bf16*)(ws + WS_H), 1024, NTOK_P, 1024}; UOrder<64> S{G, bid, NTOK_P / 256, 0};
          EpiU<64> E{(bf16*)(ws + WS_UTP)};
          pg8::gemm_phase<EpiU<64>, UOrder<64>, true, true>(lds, g, S, E); }
        { pg8::Gemm g{(const bf16*)(ws + WS_WUV) + (size_t)1024 * 1024, (const bf16*)(ws + WS_H), 512, NTOK, 1024}; pg8::StaticOrder S; S.init(512, NTOK, G, bid);
          EpiV E{ws};
          pg8::gemm_phase<EpiV, pg8::StaticOrder, true, true>(lds, g, S, E); }
    }
    SEAM(2);
    if (IN(3)) {
        int k256 = 256, k128 = 128; asm volatile("" : "+s"(k256), "+s"(k128));
        int zm = 0; asm volatile("" : "+s"(zm));
        if (bid & 1) attn_phase(a, lds, tid, lane, wave, bid, G, 0, AT_SPLIT);
        { pg8::Gemm g{(const bf16*)(ws + WS_DAS), (const bf16*)(ws + WS_UTS), 256, 8 * 512 * 64, k256}; RowOrder S{G, bid, 8 * 512 * 64 / 256, 0, zm};
          EpiA<128> E{(bf16*)(ws + WS_YS)};
          pg8::gemm_phase<EpiA<128>, RowOrder, true, true>(lds, g, S, E); }
        { pg8::Gemm g{(const bf16*)(ws + WS_DAP), (const bf16*)(ws + WS_UTP), 256, 4 * 512 * 64, k128}; RowOrder S{G, bid, 4 * 512 * 64 / 256, 0, zm};
          EpiA<64> E{(bf16*)(ws + WS_YP)};
          pg8::gemm_phase<EpiA<64>, RowOrder, true, true>(lds, g, S, E); }
        if (!(bid & 1)) attn_phase(a, lds, tid, lane, wave, bid, G, 0, AT_SPLIT);
    }
    SEAM(3);
    if (IN(4)) {   int k128 = 128; asm volatile("" : "+s"(k128));
        if (bid & 1) attn_phase(a, lds, tid, lane, wave, bid, G, AT_SPLIT, 1 << 20);
        { pg8::Gemm g{(const bf16*)(ws + WS_DBS), (const bf16*)(ws + WS_YS), 128 * 256, 8 * 128 * 512, k128}; RowOrder S{G, bid, 8 * 128 * 512 / 256, 1, 127};
          EpiB<128> E{(bf16*)(ws + WS_CAT), (float*)(ws + WS_SSQF), NTOK_P};
          pg8::gemm_phase<EpiB<128>, RowOrder, true, true>(lds, g, S, E); }
        { pg8::Gemm g{(const bf16*)(ws + WS_DBP), (const bf16*)(ws + WS_YP), 64 * 256, 4 * 64 * 512, k128}; RowOrder S{G, bid, 4 * 64 * 512 / 256, 1, 63};
          EpiB<64> E{(bf16*)(ws + WS_CAT), (float*)(ws + WS_SSQF), 0};
          pg8::gemm_phase<EpiB<64>, RowOrder, true, true>(lds, g, S, E); }
        if (!(bid & 1)) attn_phase(a, lds, tid, lane, wave, bid, G, AT_SPLIT, 1 << 20);
    }
    SEAM(4);
    if (IN(5)) {
        pg8::Gemm g{(const bf16*)(ws + WS_CAT), (const bf16*)(ws + WS_WO), NTOK, 1024, 1024}; pg8::StaticOrder S; S.init(NTOK, 1024, G, bid);
        LAS float* rs = (LAS float*)(lds + 131072 + 1024);
        { const float* sf = (const float*)(ws + WS_SSQF); const float* sa = (const float*)(ws + WS_SSQA); Unit uu;
          for (int i = 0; i < 7 && S.next(i, uu); ++i) if (tid < 256) { const int tok = uu.pm * 256 + tid;
              const float qa = sa[tok] * (1.0f / 512.0f) + EPS, qf = sf[tok] * (1.0f / 512.0f) + EPS; rs[i * 512 + 2 * tid] = sqrtf(qa / qf); rs[i * 512 + 2 * tid + 1] = rsqrtf(qa); }
          __syncthreads(); }
        EpiWo E{a.xp, a.xs, (bf16*)(ws + WS_XB), (const float*)(ws + WS_MOD), (float*)(ws + WS_SSQ), rs};
        pg8::gemm_phase<EpiWo, pg8::StaticOrder, true, true>(lds, g, S, E);
    }
    SEAM(5);
    if (IN(6)) norm_rows<true>(a, (const float*)(ws + WS_XB), nullptr, a.g_ffn, 3072, 4096, (const float*)(ws + WS_SSQ), (bf16*)(ws + WS_H), lane, gw, NGW);
    SEAM(6);
    if (IN(7)) {
        pg8::Gemm g{(const bf16*)(ws + WS_H), (const bf16*)(ws + WS_WGU), NTOK, 2 * DFF, 1024}; pg8::StaticOrder S; S.init(NTOK, 2 * DFF, G, bid);
        EpiUp E{(bf16*)(ws + WS_HID)};
        pg8::gemm_phase<EpiUp, pg8::StaticOrder, true, true>(lds, g, S, E);
    }
    SEAM(7);
    if (IN(8)) {
        pg8::Gemm g{(const bf16*)(ws + WS_HID), (const bf16*)(ws + WS_WD), NTOK, 1024, DFF}; DownOrder S; S.init(NTOK, 1024, G, bid);
        EpiDown E{a.out, (const bf16*)(ws + WS_XB), (const float*)(ws + WS_MOD), (LAS float*)(lds + 131072 + 1024)};
        pg8::gemm_phase<EpiDown, DownOrder, true, true>(lds, g, S, E);
    }
#undef IN
#undef SEAM
}

#ifndef MK_N_LAUNCHES
#define MK_N_LAUNCHES 1
#endif
extern "C" void kernel_launch(void* const* d_in, const int* in_sizes, int n_in, void* d_out, int out_size, void* d_ws, size_t ws_size, hipStream_t stream) {
    static int grid = 0;
    if (grid == 0) {
        if (n_in != 19 || out_size != NTOK * D || ws_size < WS_END) { fprintf(stderr, "kernel_launch: unexpected shapes (n_in %d, out %d, ws %zu)\n", n_in, out_size, ws_size); grid = -1; return; }
        int dev = 0, cus = 0, per_cu = 0;
        hipGetDevice(&dev); hipDeviceGetAttribute(&cus, hipDeviceAttributeMultiprocessorCount, dev);
        if (hipFuncSetAttribute((const void*)fwd_mega, hipFuncAttributeMaxDynamicSharedMemorySize, LDS_BYTES) != hipSuccess) { fprintf(stderr, "kernel_launch: hipFuncSetAttribute failed\n"); grid = -1; return; }
        hipOccupancyMaxActiveBlocksPerMultiprocessor(&per_cu, (const void*)fwd_mega, 512, LDS_BYTES);
        (void)hipGetLastError();
        if (per_cu < 1) { fprintf(stderr, "kernel_launch: occupancy query says %d blocks per CU\n", per_cu); per_cu = 1; }
        grid = cus;
    }
    if (grid < 0) return;
    hipMemsetAsync((char*)d_ws + WS_SSQ, 0, 1 * MiB, stream);
    Args a{};
    a.xp = (const float*)d_in[0]; a.xs = (const float*)d_in[1]; a.cp = (const float*)d_in[2]; a.cs = (const float*)d_in[3]; a.w_ada = (const float*)d_in[4]; a.b_ada = (const float*)d_in[5];
    a.g_attn = (const float*)d_in[6]; a.w_in = (const float*)d_in[7]; a.g_q = (const float*)d_in[8]; a.g_k = (const float*)d_in[9]; a.w_fmix = (const float*)d_in[10]; a.rpb = (const float*)d_in[11];
    a.g_fout = (const float*)d_in[12]; a.g_aout = (const float*)d_in[13]; a.w_o = (const float*)d_in[14]; a.g_ffn = (const float*)d_in[15]; a.w_gate = (const float*)d_in[16]; a.w_up = (const float*)d_in[17];
    a.w_down = (const float*)d_in[18]; a.out = (float*)d_out; a.ws = (unsigned char*)d_ws;
#if MK_N_LAUNCHES == 1
    a.ph_lo = 0; a.ph_hi = 9;
    void* args[] = {&a};
    hipError_t e = hipLaunchCooperativeKernel((const void*)fwd_mega, dim3(grid), dim3(512), args, LDS_BYTES, stream);
    if (e != hipSuccess) fprintf(stderr, "kernel_launch: cooperative launch failed: %s (grid %d)\n", hipGetErrorString(e), grid);
#else
    for (int p = 0; p < 9; ++p) { a.ph_lo = p; a.ph_hi = p + 1; hipLaunchKernelGGL(fwd_mega, dim3(grid), dim3(512), LDS_BYTES, stream, a); }
#endif
}
```
